# Optimizing an MI355X kernel written in HIP

```python
import math
import jax, jax.numpy as jnp
from jax import lax
import numpy as np

D_MODEL = 1024
BATCH = 4
SEQ = 8192
DEPTH = 2

MEM_LEN = 256
HEAD_DIM = 64
NSA_HEADS = 8
NSA_KV_HEADS = 2
NSA_HPG = NSA_HEADS // NSA_KV_HEADS
NSA_WIDTH = NSA_HEADS * HEAD_DIM
KV_WIDTH = NSA_KV_HEADS * HEAD_DIM
CMP_BLOCK = 64
SEL_TOPN = 16
WINDOW = 512
Q_BLOCK = 128
FORCE_SCORE = 1e4
LRU_WIDTH = D_MODEL // 2
LRU_BLOCKS = 8
LRU_BLOCK_DIM = LRU_WIDTH // LRU_BLOCKS
CONV_WIDTH = 4
LRU_C = 8.0
MIX_WIDTH = NSA_WIDTH + LRU_WIDTH
IN_COLS = NSA_WIDTH + 6 * KV_WIDTH + 3 * NSA_HEADS + 2 * LRU_WIDTH
X_HEADS = 4
X_HEAD_DIM = D_MODEL // X_HEADS
D_FF = 4 * D_MODEL
N_BUCKETS = 32
MAX_DISTANCE = 128
EPS = 1e-6
NEG = -1e30

kernel_name = "hymba_nsa_rglru_sandwich_trunk"


def rmsnorm(x, g):
    xf = x.astype(jnp.float32)
    r = xf * lax.rsqrt(jnp.mean(xf * xf, axis=-1, keepdims=True) + EPS)
    return (r * g.astype(jnp.float32)).astype(x.dtype)


def masked_softmax(logits, mask):
    l = jnp.where(mask, logits.astype(jnp.float32), NEG)
    m = jnp.max(l, axis=-1, keepdims=True)
    e = jnp.where(mask, jnp.exp(l - m), 0.0)
    return e / jnp.maximum(jnp.sum(e, axis=-1, keepdims=True), 1e-30)


def t5_bucket(dist):
    max_exact = N_BUCKETS // 2
    d = jnp.maximum(dist, 0)
    df = jnp.maximum(d, 1).astype(jnp.float32)
    large = max_exact + (jnp.log(df / max_exact) / math.log(MAX_DISTANCE / max_exact)
                         * (N_BUCKETS - max_exact)).astype(jnp.int32)
    large = jnp.minimum(large, N_BUCKETS - 1)
    return jnp.where(d < max_exact, d, large)


def nsa_attention(q, kc_raw, vc_raw, ks, vs, kw, vw, gates, pe_k, pe_v, w_ck, w_cv, rel_bias):
    B, S = q.shape[0], q.shape[1]
    G, HPG, Dh = NSA_KV_HEADS, NSA_HPG, HEAD_DIM
    nb = S // CMP_BLOCK
    n_sel = min(SEL_TOPN, nb)
    scale = Dh ** -0.5

    def compress(raw, pe, w):
        blocks = raw.reshape(B, nb, CMP_BLOCK, G, Dh) + pe[None, None, :, None, :]
        return jnp.einsum('bnrgd,rde->bnge', blocks, w)

    kc = compress(kc_raw, pe_k, w_ck)
    vc = compress(vc_raw, pe_v, w_cv)
    ks_blk = ks.reshape(B, nb, CMP_BLOCK, G, Dh).transpose(0, 3, 1, 2, 4)
    vs_blk = vs.reshape(B, nb, CMP_BLOCK, G, Dh).transpose(0, 3, 1, 2, 4)
    kw_pad = jnp.pad(kw, ((0, 0), (WINDOW, 0), (0, 0), (0, 0)))
    vw_pad = jnp.pad(vw, ((0, 0), (WINDOW, 0), (0, 0), (0, 0)))
    bias_g = rel_bias.reshape(N_BUCKETS, G, HPG)
    blk_idx = jnp.arange(nb)
    blk_end = blk_idx * CMP_BLOCK + CMP_BLOCK - 1
    b_ix = jnp.arange(B)[:, None, None, None]
    g_ix = jnp.arange(G)[None, :, None, None]

    def one_block(s0):
        t = s0 + jnp.arange(Q_BLOCK)
        qb = lax.dynamic_slice_in_dim(q, s0, Q_BLOCK, axis=1)
        gb = lax.dynamic_slice_in_dim(gates, s0, Q_BLOCK, axis=1)

        dist_c = t[:, None] - blk_end[None, :]
        mask_c = dist_c >= 0
        bias_c = bias_g[t5_bucket(dist_c)].transpose(2, 3, 0, 1)
        s_c = jnp.einsum('bqghd,bngd->bghqn', qb, kc) * scale + bias_c
        p_c = masked_softmax(s_c, mask_c)
        o_c = jnp.einsum('bghqn,bngd->bqghd', p_c.astype(vc.dtype), vc)

        importance = jnp.sum(p_c, axis=2)
        cur = (t // CMP_BLOCK)[:, None]
        j = blk_idx[None, :]
        forced = (j == 0) | (j == cur) | (j == cur - 1)
        sel_score = jnp.where(j <= cur, jnp.where(forced, FORCE_SCORE, importance), NEG)
        top_val, top_idx = lax.top_k(sel_score, n_sel)
        blk_valid = top_val > NEG / 2
        k_sel = ks_blk[b_ix, g_ix, top_idx]
        v_sel = vs_blk[b_ix, g_ix, top_idx]
        pos = top_idx[..., None] * CMP_BLOCK + jnp.arange(CMP_BLOCK)
        dist_s = t[None, None, :, None, None] - pos
        mask_s = blk_valid[..., None] & (dist_s >= 0)
        bias_s = jnp.moveaxis(bias_g[t5_bucket(dist_s), g_ix[..., None]], -1, 2)
        s_s = jnp.einsum('bqghd,bgqnrd->bghqnr', qb, k_sel) * scale + bias_s
        flat = (B, G, HPG, Q_BLOCK, n_sel * CMP_BLOCK)
        mask_s_full = jnp.broadcast_to(mask_s[:, :, None], s_s.shape).reshape(flat)
        p_s = masked_softmax(s_s.reshape(flat), mask_s_full).reshape(s_s.shape)
        o_s = jnp.einsum('bghqnr,bgqnrd->bqghd', p_s.astype(v_sel.dtype), v_sel)

        kwb = lax.dynamic_slice_in_dim(kw_pad, s0, WINDOW + Q_BLOCK, axis=1)
        vwb = lax.dynamic_slice_in_dim(vw_pad, s0, WINDOW + Q_BLOCK, axis=1)
        kpos = s0 - WINDOW + jnp.arange(WINDOW + Q_BLOCK)
        dist_w = t[:, None] - kpos[None, :]
        mask_w = (kpos[None, :] >= 0) & (dist_w >= 0) & (dist_w < WINDOW)
        bias_w = bias_g[t5_bucket(dist_w)].transpose(2, 3, 0, 1)
        s_w = jnp.einsum('bqghd,bkgd->bghqk', qb, kwb) * scale + bias_w
        p_w = masked_softmax(s_w, mask_w)
        o_w = jnp.einsum('bghqk,bkgd->bqghd', p_w.astype(vwb.dtype), vwb)

        g = jax.nn.sigmoid(gb.astype(jnp.float32))
        out = g[..., 0:1] * o_c + g[..., 1:2] * o_s + g[..., 2:3] * o_w
        return out.reshape(B, Q_BLOCK, NSA_WIDTH).astype(q.dtype)

    starts = jnp.arange(S // Q_BLOCK) * Q_BLOCK
    outs = lax.map(one_block, starts)
    return outs.transpose(1, 0, 2, 3).reshape(B, S, NSA_WIDTH)


def rg_lru_branch(xg, xr, conv_w, conv_b, w_a, b_a, w_x, b_x, lam):
    B, S, _ = xr.shape
    y = jax.nn.gelu(xg)
    xp = jnp.pad(xr, ((0, 0), (CONV_WIDTH - 1, 0), (0, 0)))
    xc = conv_b + sum(xp[:, k:k + S] * conv_w[k] for k in range(CONV_WIDTH))
    xb = xc.reshape(B, S, LRU_BLOCKS, LRU_BLOCK_DIM)
    r = jax.nn.sigmoid(jnp.einsum('bsnd,nde->bsne', xb, w_a).reshape(B, S, LRU_WIDTH) + b_a)
    i = jax.nn.sigmoid(jnp.einsum('bsnd,nde->bsne', xb, w_x).reshape(B, S, LRU_WIDTH) + b_x)
    log_a = -LRU_C * jax.nn.softplus(-lam.astype(jnp.float32)) * r.astype(jnp.float32)
    a = jnp.exp(log_a)
    b = jnp.sqrt(-jnp.expm1(2.0 * log_a)) * (i * xc).astype(jnp.float32)

    def combine(left, right):
        a1, b1 = left
        a2, b2 = right
        return a1 * a2, a2 * b1 + b2

    _, h = lax.associative_scan(combine, (a, b), axis=1)
    return h.astype(xr.dtype) * y


def setup_inputs(seed: int = 0) -> dict:
    key = jax.random.key(seed)
    ks = jax.random.split(key, 32)
    f32 = jnp.float32

    def nrm(k, shape, scale):
        return jax.random.normal(k, shape, f32) * scale

    def gain(k, shape):
        return 1.0 + 0.05 * jax.random.normal(k, shape, f32)

    L, D = DEPTH, D_MODEL
    a8 = jax.random.uniform(ks[20], (L, LRU_WIDTH), f32, minval=0.9, maxval=0.999)
    a = a8 ** (1.0 / LRU_C)
    lam = jnp.log(a) - jnp.log1p(-a)
    return {
        "x": nrm(ks[0], (BATCH, SEQ, D), 1.0),
        "mem": nrm(ks[1], (BATCH, MEM_LEN, D), 1.0),
        "rel_bias": nrm(ks[2], (N_BUCKETS, NSA_HEADS), 0.5),
        "ln_mix_pre": gain(ks[3], (L, D)),
        "ln_mix_post": gain(ks[4], (L, D)),
        "w_in": nrm(ks[5], (L, D, IN_COLS), D ** -0.5),
        "cmp_pe_k": nrm(ks[6], (L, CMP_BLOCK, HEAD_DIM), 0.1),
        "cmp_pe_v": nrm(ks[7], (L, CMP_BLOCK, HEAD_DIM), 0.1),
        "cmp_w_k": nrm(ks[8], (L, CMP_BLOCK, HEAD_DIM, HEAD_DIM), (CMP_BLOCK * HEAD_DIM) ** -0.5),
        "cmp_w_v": nrm(ks[9], (L, CMP_BLOCK, HEAD_DIM, HEAD_DIM), (CMP_BLOCK * HEAD_DIM) ** -0.5),
        "conv_w": nrm(ks[10], (L, CONV_WIDTH, LRU_WIDTH), CONV_WIDTH ** -0.5),
        "conv_b": nrm(ks[11], (L, LRU_WIDTH), 0.02),
        "lru_wa": nrm(ks[12], (L, LRU_BLOCKS, LRU_BLOCK_DIM, LRU_BLOCK_DIM), LRU_BLOCK_DIM ** -0.5),
        "lru_ba": nrm(ks[13], (L, LRU_WIDTH), 0.02),
        "lru_wx": nrm(ks[14], (L, LRU_BLOCKS, LRU_BLOCK_DIM, LRU_BLOCK_DIM), LRU_BLOCK_DIM ** -0.5),
        "lru_bx": nrm(ks[15], (L, LRU_WIDTH), 0.02),
        "lru_lambda": lam,
        "gn_attn": gain(ks[16], (L, NSA_WIDTH)),
        "gn_lru": gain(ks[17], (L, LRU_WIDTH)),
        "w_out": nrm(ks[18], (L, MIX_WIDTH, D), MIX_WIDTH ** -0.5),
        "ln_x_pre": gain(ks[19], (L, D)),
        "ln_x_post": gain(ks[21], (L, D)),
        "ln_mem": gain(ks[22], (L, D)),
        "xq": nrm(ks[23], (L, D, D), D ** -0.5),
        "xkv": nrm(ks[24], (L, D, 2 * D), D ** -0.5),
        "xo": nrm(ks[25], (L, D, D), D ** -0.5),
        "ln_mlp_pre": gain(ks[26], (L, D)),
        "ln_mlp_post": gain(ks[27], (L, D)),
        "mlp_w1": nrm(ks[28], (L, D, D_FF), D ** -0.5),
        "mlp_w2": nrm(ks[29], (L, D_FF, D), D_FF ** -0.5),
    }


def reference(x, mem, rel_bias, ln_mix_pre, ln_mix_post, w_in, cmp_pe_k, cmp_pe_v, cmp_w_k, cmp_w_v,
              conv_w, conv_b, lru_wa, lru_ba, lru_wx, lru_bx, lru_lambda, gn_attn, gn_lru, w_out,
              ln_x_pre, ln_x_post, ln_mem, xq, xkv, xo, ln_mlp_pre, ln_mlp_post, mlp_w1, mlp_w2):
    B, S, D = x.shape
    M = mem.shape[1]
    sizes = [NSA_WIDTH] + [KV_WIDTH] * 6 + [3 * NSA_HEADS, LRU_WIDTH, LRU_WIDTH]
    offsets = [int(o) for o in np.cumsum(sizes)[:-1]]
    for l in range(DEPTH):
        h = rmsnorm(x, ln_mix_pre[l])
        z = h @ w_in[l]
        q, kc, vc, ksl, vsl, kwn, vwn, gt, xg, xr = jnp.split(z, offsets, axis=-1)
        kvshape = (B, S, NSA_KV_HEADS, HEAD_DIM)
        att = nsa_attention(
            q.reshape(B, S, NSA_KV_HEADS, NSA_HPG, HEAD_DIM),
            kc.reshape(kvshape), vc.reshape(kvshape), ksl.reshape(kvshape), vsl.reshape(kvshape),
            kwn.reshape(kvshape), vwn.reshape(kvshape),
            gt.reshape(B, S, NSA_KV_HEADS, NSA_HPG, 3),
            cmp_pe_k[l], cmp_pe_v[l], cmp_w_k[l], cmp_w_v[l], rel_bias)
        lru = rg_lru_branch(xg, xr, conv_w[l], conv_b[l], lru_wa[l], lru_ba[l],
                            lru_wx[l], lru_bx[l], lru_lambda[l])
        mixed = jnp.concatenate([rmsnorm(att, gn_attn[l]), rmsnorm(lru, gn_lru[l])], axis=-1) @ w_out[l]
        x = x + rmsnorm(mixed, ln_mix_post[l])

        h = rmsnorm(x, ln_x_pre[l])
        mn = rmsnorm(mem, ln_mem[l])
        cq = (h @ xq[l]).reshape(B, S, X_HEADS, X_HEAD_DIM)
        ck, cv = jnp.split((mn @ xkv[l]).reshape(B, M, 2, X_HEADS, X_HEAD_DIM), 2, axis=2)
        ck, cv = ck[:, :, 0], cv[:, :, 0]
        s = jnp.einsum('bshd,bmhd->bhsm', cq, ck).astype(jnp.float32) * (X_HEAD_DIM ** -0.5)
        p = jax.nn.softmax(s, axis=-1).astype(cv.dtype)
        co = jnp.einsum('bhsm,bmhd->bshd', p, cv).reshape(B, S, D) @ xo[l]
        x = x + rmsnorm(co, ln_x_post[l])

        h = rmsnorm(x, ln_mlp_pre[l])
        u = jnp.square(jax.nn.relu(h @ mlp_w1[l]))
        x = x + rmsnorm(u @ mlp_w2[l], ln_mlp_post[l])
    return x
```

```cpp
#include <hip/hip_runtime.h>
#include <hip/hip_cooperative_groups.h>
#include <cstdio>
#include <cstdint>
namespace cg = cooperative_groups;

#define LAS __attribute__((address_space(3)))
typedef unsigned short bf16_t;
typedef short bf16x8 __attribute__((ext_vector_type(8)));
typedef short s16x4 __attribute__((ext_vector_type(4)));
typedef float f32x2 __attribute__((ext_vector_type(2)));
typedef float f32x4 __attribute__((ext_vector_type(4)));
typedef float f32x16 __attribute__((ext_vector_type(16)));
typedef unsigned u32x2 __attribute__((ext_vector_type(2)));
typedef unsigned u32x4 __attribute__((ext_vector_type(4)));
typedef int i32x4 __attribute__((ext_vector_type(4)));
typedef int i32x8 __attribute__((ext_vector_type(8)));

constexpr int NB_ = 4, S_ = 8192, T_ = NB_ * S_, D_ = 1024, NL_ = 2, FF_ = 4096, MEM_ = 256;
constexpr int INC_ = 2328;
constexpr float EPS_ = 1e-6f, NEG_ = -1e30f, LOG2E_ = 1.4426950408889634f;
constexpr float C2_ = 0.125f * LOG2E_, XC2_ = 0.0625f * LOG2E_;

constexpr size_t MiB = 1u << 20;
constexpr size_t WS_PEP = 1 * MiB;
constexpr size_t WS_W = 2 * MiB, WL_STRIDE = 33 * MiB;
constexpr size_t W_INA = 0, W_INV = 4 * MiB, W_OUT = 5 * MiB, W_XQ = 7 * MiB, W_XK = 9 * MiB, W_XV = 11 * MiB, W_XO = 13 * MiB,
                 W_1 = 15 * MiB, W_2 = 23 * MiB, W_CK = 31 * MiB, W_CV = 31 * MiB + 512 * 1024, W_A = 32 * MiB, W_X = 32 * MiB + 65536;
constexpr size_t WS_MNB = 68 * MiB;
constexpr size_t WS_CK = 70 * MiB;
constexpr size_t WS_CVT = 74 * MiB;
constexpr size_t WS_KCB = 78 * MiB;
constexpr size_t WS_VCT = 79 * MiB;
constexpr size_t WS_AGG = 80 * MiB;
constexpr size_t WS_RS = 82 * MiB;
constexpr size_t WS_HB = 84 * MiB;
constexpr size_t WS_SLOT = 148 * MiB;
constexpr size_t WS_AGG2 = 150 * MiB;
constexpr size_t WS_U = 212 * MiB;
constexpr size_t WS_QB = WS_U;
constexpr size_t WS_KP = WS_U + 32 * MiB;
constexpr size_t WS_VT = WS_U + 56 * MiB;
constexpr size_t WS_GATES = WS_U + 88 * MiB;
constexpr size_t WS_YG = WS_U + 92 * MiB;
constexpr size_t WS_XR = WS_U + 124 * MiB;
constexpr size_t WS_AB = WS_U + 156 * MiB;
constexpr size_t WS_KF = WS_U + 220 * MiB;
constexpr size_t WS_VF = WS_U + 228 * MiB;
constexpr size_t WS_CQ = WS_U;
constexpr size_t WS_PP = WS_U + 64 * MiB;
constexpr size_t WS_CO = WS_U + 128 * MiB;
constexpr size_t WS_END = WS_U + 256 * MiB;

constexpr float U8_SCALE = 8.0f  , W8_SCALE = 1024.0f;
constexpr int LDS_BYTES = 147456;
constexpr int RING_BYTES = 131072;
constexpr int NTHREADS = 512;

__device__ __forceinline__ unsigned f2bf(float f) { unsigned u = __builtin_bit_cast(unsigned, f); return (u + 0x7fffu + ((u >> 16) & 1u)) >> 16; }
__device__ __forceinline__ unsigned pk2(float lo, float hi) { unsigned r; asm("v_cvt_pk_bf16_f32 %0, %1, %2" : "=v"(r) : "v"(lo), "v"(hi)); return r; }
__device__ __forceinline__ unsigned cvt_pk_bf16(float lo, float hi) { unsigned r; asm volatile("v_cvt_pk_bf16_f32 %0, %1, %2" : "=v"(r) : "v"(lo), "v"(hi)); return r; }
__device__ __forceinline__ float bflo(unsigned w) { return __builtin_bit_cast(float, w << 16); }
__device__ __forceinline__ float bfhi(unsigned w) { return __builtin_bit_cast(float, w & 0xffff0000u); }
__device__ __forceinline__ float bf2f(bf16_t h) { return __builtin_bit_cast(float, (unsigned)h << 16); }
__device__ __forceinline__ float ex2(float x) { return __builtin_amdgcn_exp2f(x); }
__device__ __forceinline__ float rcp(float x) { return __builtin_amdgcn_rcpf(x); }
__device__ __forceinline__ float sigmoidf_(float x) { return rcp(1.0f + ex2(-LOG2E_ * x)); }
__device__ __forceinline__ float gelu_tanh(float x) { const float z = x + 0.044715f * x * x * x; return x * rcp(1.0f + ex2(-2.302208198f * z)); }
__device__ __forceinline__ float rs_of(f32x4 p) { return __builtin_amdgcn_rsqf(((p.x + p.y) + (p.z + p.w)) * (1.f / D_) + EPS_); }
__device__ __forceinline__ int crow(int r, int hi) { return (r & 3) + 8 * (r >> 2) + 4 * hi; }
__device__ __forceinline__ int lane_v() { int l; asm volatile("v_mbcnt_lo_u32_b32 %0, -1, 0\n\tv_mbcnt_hi_u32_b32 %0, -1, %0" : "=v"(l)); return l; }
__device__ __forceinline__ int tid_of(int wave) { return (wave << 6) | lane_v(); }
__device__ __forceinline__ float shx(float v, int m) { return __int_as_float(__builtin_amdgcn_ds_bpermute((lane_v() ^ m) << 2, __float_as_int(v))); }
__device__ __forceinline__ int shup8(int v, int d) { const int s = lane_v(); return __builtin_amdgcn_ds_bpermute((((s & 7) >= d) ? s - d : s) << 2, v); }
__device__ __forceinline__ float wave_sum(float v) {
    const int l_ = lane_v();
#pragma unroll
    for (int o = 1; o < 64; o <<= 1) v += __int_as_float(__builtin_amdgcn_ds_bpermute((l_ ^ o) << 2, __float_as_int(v)));
    return v;
}
#define LDS_WAIT() asm volatile("s_waitcnt lgkmcnt(0)" ::: "memory")
#define VM_WAIT() asm volatile("s_waitcnt vmcnt(0)" ::: "memory")

namespace pg8 {
constexpr int BM = 256, BK = 64, HALF = 128, HTB = HALF * BK * 2, STAGE_BYTES = 8 * HTB, NXCD = 8, WGM = 8;
__device__ __forceinline__ int lds_byte(int r, int c) { const int st = (r >> 4) * 2 + (c >> 5), rr = r & 15, cc = c & 31, ob = rr * 64 + cc * 2; return st * 1024 + (ob ^ (((ob >> 9) & 1) << 5)); }
__device__ __forceinline__ void stage_rc(int b, int& R, int& C) { const int st = b / 1024, sb = b % 1024, swz = sb ^ (((sb >> 9) & 1) << 5); R = (st >> 1) * 16 + swz / 64; C = (st & 1) * 32 + (swz % 64) / 2; }
__device__ __forceinline__ int perm32(int rho) { const int n = rho >> 4, i = rho & 15; return 8 * (i >> 2) + 4 * n + (i & 3); }

struct Unit { int pm, pn; long aoff, boff; };
struct Gemm { const bf16_t* A; const bf16_t* Bt; int lda, ldb, K; };

struct TileOrder {
    int nM, nN, nwg, G, c; long astep, bstep;
    __device__ void init(int M, int N, int lda, int ldb, int G_, int c_) { nM = M / BM; nN = N / BM; nwg = nM * nN; G = G_; c = c_; astep = (long)BM * lda * 2; bstep = (long)BM * ldb * 2; }
    __device__ bool next(int i, Unit& u) const {
        const long L = (long)i * G + c; if (L >= nwg) return false;
        int wgid = (int)L; { const int q = nwg / NXCD, r = nwg % NXCD, xcd = wgid % NXCD, off = wgid / NXCD; wgid = (xcd < r ? xcd * (q + 1) : r * (q + 1) + (xcd - r) * q) + off; }
        const int nig = WGM * nN, gid = wgid / nig, fm = gid * WGM, gsz = (nM - fm) < WGM ? (nM - fm) : WGM;
        u.pm = fm + ((wgid % nig) % gsz); u.pn = (wgid % nig) / gsz; u.aoff = u.pm * astep; u.boff = u.pn * bstep; return true;
    }
};
struct ResidOrder {
    int kind; TileOrder t;
    __device__ bool next(int i, Unit& u) const {
        if (kind == 0) return t.next(i, u);
        const long L = (long)i * t.G + t.c; if (L >= 512) return false;
        u.pm = (int)L >> 2; u.pn = (int)L & 3; u.aoff = u.pm * t.astep; u.boff = u.pn * t.bstep; return true;
    }
};
struct GenOrder {
    int kind; TileOrder t;
    __device__ bool next(int i, Unit& u) const {
        if (kind == 0) return t.next(i, u);
        if (kind >= 4) { if (!t.next(i, u)) return false;
            const int h = u.pn, pmg = u.pm, b = pmg >> 5; u.aoff = ((long)pmg * 256 * 1024 + h * 256) * 2;
            u.boff = kind == 4 ? ((long)b * 256 * 1024 + h * 256) * 2 : ((long)h * 256 * 1024 + b * 256) * 2; return true; }
        const long L = (long)i * t.G + t.c; if (L >= 512) return false;
        const int h = (int)L & 3, pmg = (int)L >> 2, b = pmg >> 5;
        u.pm = pmg; u.pn = h; u.aoff = ((long)pmg * 256 * 1024 + h * 256) * 2;
        u.boff = kind == 1 ? ((long)b * 256 * 1024 + h * 256) * 2 : ((long)h * 256 * 1024 + b * 256) * 2; return true;
    }
};

struct EpiBf16 {
    static constexpr bool NEEDS_LDS = false, RS_PREFETCH = true;
    bf16_t* O; long ldc; int row_limit; int act; const float* rs; int rs_mode; bf16_t* vf;
    __device__ __forceinline__ void operator()(f32x4 (&acc)[2][2][4][2], const Unit& u, int wr, int wc, int fr, int fq, LAS unsigned char* xl) const {
        asm volatile("" : "+v"(fr), "+v"(fq));
        const int row0 = u.pm * BM + wr * 64 + fr; const int col0 = u.pn * BM + wc * 32 + 8 * fq;
        float rs8[2][4];
#pragma unroll
        for (int ai = 0; ai < 2; ++ai)
#pragma unroll
            for (int m = 0; m < 4; ++m) rs8[ai][m] = rs_mode == 1 ? rs_of(*(const LAS f32x4*)(xl + (wr * 64 + fr + ai * HALF + m * 16) * 16)) : 1.0f;
        if (act == 2) {
            const int odd = fq & 1;
            unsigned char* lane0 = (unsigned char*)O + (size_t)(row0 + odd * 16) * ldc + col0 - odd * 8;
#pragma unroll
            for (int ai = 0; ai < 2; ++ai)
#pragma unroll
                for (int mp = 0; mp < 2; ++mp)
#pragma unroll
                    for (int bj = 0; bj < 2; ++bj) { unsigned pq[2][2];
#pragma unroll
                        for (int k = 0; k < 2; ++k) { const int m = 2 * mp + k; const float r2 = rs8[ai][m] * 2.8284271f; f32x4 z0 = acc[ai][bj][m][0] * r2, z1 = acc[ai][bj][m][1] * r2;
#pragma unroll
                            for (int e = 0; e < 4; ++e) { z0[e] = __builtin_amdgcn_fmed3f(z0[e], 0.f, 21.16f); z1[e] = __builtin_amdgcn_fmed3f(z1[e], 0.f, 21.16f); }
                            z0 *= z0; z1 *= z1;
                            int p0 = __builtin_amdgcn_cvt_pk_fp8_f32(z0[0], z0[1], 0, false); p0 = __builtin_amdgcn_cvt_pk_fp8_f32(z0[2], z0[3], p0, true);
                            int p1 = __builtin_amdgcn_cvt_pk_fp8_f32(z1[0], z1[1], 0, false); p1 = __builtin_amdgcn_cvt_pk_fp8_f32(z1[2], z1[3], p1, true);
                            pq[k][0] = (unsigned)p0; pq[k][1] = (unsigned)p1; }
                        const auto s0 = __builtin_amdgcn_permlane16_swap(pq[0][0], pq[1][0], false, false), s1 = __builtin_amdgcn_permlane16_swap(pq[0][1], pq[1][1], false, false);
                        *(u32x4*)(lane0 + (size_t)(ai * HALF + mp * 32) * ldc + bj * HALF) = (u32x4){s0[0], s1[0], s0[1], s1[1]}; }
            return; }
        if (act == 0 && rs_mode != 2 && vf == nullptr && row_limit >= (1 << 30)) {
#pragma unroll
            for (int ai = 0; ai < 2; ++ai)
#pragma unroll
                for (int m = 0; m < 4; ++m) { const float rsr = rs8[ai][m]; bf16_t* rowp = O + (size_t)(row0 + ai * HALF + m * 16) * ldc + col0;
#pragma unroll
                    for (int bj = 0; bj < 2; ++bj) { const f32x4 v0 = acc[ai][bj][m][0] * rsr, v1 = acc[ai][bj][m][1] * rsr;
                        u32x4 w; w.x = cvt_pk_bf16(v0[0], v0[1]); w.y = cvt_pk_bf16(v0[2], v0[3]); w.z = cvt_pk_bf16(v1[0], v1[1]); w.w = cvt_pk_bf16(v1[2], v1[3]);
                        *(u32x4*)(rowp + bj * HALF) = w; } }
            return; }
#pragma unroll
        for (int bj = 0; bj < 2; ++bj) { f32x4 cs0 = (f32x4){1.f, 1.f, 1.f, 1.f}, cs1 = cs0;
            if (rs_mode == 2) {
#pragma unroll
                for (int e = 0; e < 4; ++e) { cs0[e] = rs_of(((const f32x4*)rs)[col0 + bj * HALF + e]); cs1[e] = rs_of(((const f32x4*)rs)[col0 + bj * HALF + 4 + e]); } }
#pragma unroll
            for (int ai = 0; ai < 2; ++ai)
#pragma unroll
                for (int m = 0; m < 4; ++m) { const int row = row0 + ai * HALF + m * 16; if (row >= row_limit) continue; bf16_t* rowp = O + (size_t)row * ldc + col0;
                    const float rsr = rs8[ai][m];
                    f32x4 v0 = acc[ai][bj][m][0] * rsr, v1 = acc[ai][bj][m][1] * rsr;
                    if (rs_mode == 2) { v0 *= cs0; v1 *= cs1; }
                    if (act >= 1) {
#pragma unroll
                        for (int e = 0; e < 4; ++e) { const float a = fmaxf(v0[e], 0.f), b = fmaxf(v1[e], 0.f); v0[e] = a * a; v1[e] = b * b; } }
                    u32x4 w; w.x = cvt_pk_bf16(v0[0], v0[1]); w.y = cvt_pk_bf16(v0[2], v0[3]); w.z = cvt_pk_bf16(v1[0], v1[1]); w.w = cvt_pk_bf16(v1[2], v1[3]);
                    *(u32x4*)(rowp + bj * HALF) = w;
                    if (vf && row >= 128 && row < 256) { const int g = (row >> 6) & 1, d = row & 63, col = col0 + bj * HALF, k0 = col & 63;
                        bf16_t* p = vf + ((size_t)g * (T_ / 64) + (col >> 6)) * 4096 + (((((k0 >> 5) * 2 + ((k0 >> 4) & 1)) * 2 + (d >> 5)) * 2) * 32 + (d & 31)) * 8 + 4 * ((k0 >> 3) & 1);
                        const auto s0 = __builtin_amdgcn_permlane16_swap(w.x, w.z, false, false), s1 = __builtin_amdgcn_permlane16_swap(w.y, w.w, false, false);
                        *(u32x4*)(p + ((fq & 1) ? 252 : 0)) = (u32x4){s0[0], s1[0], s0[1], s1[1]}; } } }
    }
};
struct EpiG1 {
    static constexpr bool NEEDS_LDS = false, RS_PREFETCH = true;
    bf16_t* QB; bf16_t* KP; float* GATES; bf16_t* YG; bf16_t* XR; const float* rs; bf16_t* KF;
    __device__ __forceinline__ void operator()(f32x4 (&acc)[2][2][4][2], const Unit& u, int wr, int wc, int fr, int fq, LAS unsigned char* xl) const {
        asm volatile("" : "+v"(fr), "+v"(fq));
        const int row0 = u.pm * BM + wr * 64 + fr; const int pn = u.pn; const int cl0 = wc * 32 + 8 * fq;
        float rs8[2][4];
#pragma unroll
        for (int ai = 0; ai < 2; ++ai)
#pragma unroll
            for (int m = 0; m < 4; ++m) rs8[ai][m] = rs_of(*(const LAS f32x4*)(xl + (wr * 64 + fr + ai * HALF + m * 16) * 16));
#pragma unroll
        for (int ai = 0; ai < 2; ++ai)
#pragma unroll
            for (int m = 0; m < 4; ++m) { const size_t row = (size_t)(row0 + ai * HALF + m * 16); const float rsr = rs8[ai][m];
#pragma unroll
                for (int bj = 0; bj < 2; ++bj) { f32x4 v0 = acc[ai][bj][m][0] * rsr, v1 = acc[ai][bj][m][1] * rsr;
                    bf16_t* dst = nullptr;
                    if (pn < 2) dst = QB + row * 512 + pn * 256 + bj * 128 + cl0;
                    else if (pn == 2 || (pn == 3 && bj == 0)) { const int plane = (pn == 2) ? bj : 2; const int g = cl0 >> 6, d = cl0 & 63; dst = KP + ((size_t)(plane * 2 + g) * T_ + row) * 64 + d; }
                    else if (pn == 3) {
                        if (cl0 < 24) { float* gp = GATES + row * 24 + cl0; f32x4 a, b;
#pragma unroll
                            for (int e = 0; e < 4; ++e) { a[e] = sigmoidf_(v0[e]); b[e] = sigmoidf_(v1[e]); }
                            *(f32x4*)gp = a; *(f32x4*)(gp + 4) = b; }
                        continue; }
                    else if (pn < 6) { dst = YG + row * 512 + (pn - 4) * 256 + bj * 128 + cl0;
#pragma unroll
                        for (int e = 0; e < 4; ++e) { v0[e] = gelu_tanh(v0[e]); v1[e] = gelu_tanh(v1[e]); } }
                    else dst = XR + row * 512 + (pn - 6) * 256 + bj * 128 + cl0;
                    u32x4 w; w.x = cvt_pk_bf16(v0[0], v0[1]); w.y = cvt_pk_bf16(v0[2], v0[3]); w.z = cvt_pk_bf16(v1[0], v1[1]); w.w = cvt_pk_bf16(v1[2], v1[3]);
                    *(u32x4*)dst = w;
                    if (pn == 2 && bj == 1) { const int g = cl0 >> 6, d = cl0 & 63, key = (int)row & 63;
                        *(u32x4*)(KF + ((size_t)g * (T_ / 64) + (row >> 6)) * 4096 + ((((key >> 5) * 4 + (d >> 4)) * 2 + ((d >> 3) & 1)) * 32 + (key & 31)) * 8) = w; } } }
    }
};
struct EpiSoftmax {
    static constexpr bool NEEDS_LDS = true, RS_PREFETCH = false;
    bf16_t* P;
    __device__ __forceinline__ void operator()(f32x4 (&acc)[2][2][4][2], const Unit& u, int wr, int wc, int fr, int fq, LAS unsigned char* xl) const {
        asm volatile("" : "+v"(fr), "+v"(fq));
        LAS f32x2* X = (LAS f32x2*)xl;
#pragma unroll
        for (int ai = 0; ai < 2; ++ai)
#pragma unroll
            for (int m = 0; m < 4; ++m) { float mx = NEG_;
#pragma unroll
                for (int bj = 0; bj < 2; ++bj)
#pragma unroll
                    for (int n = 0; n < 2; ++n)
#pragma unroll
                        for (int e = 0; e < 4; ++e) mx = fmaxf(mx, acc[ai][bj][m][n][e]);
                mx = fmaxf(mx, shx(mx, 16)); mx = fmaxf(mx, shx(mx, 32));
                float s = 0.f;
#pragma unroll
                for (int bj = 0; bj < 2; ++bj)
#pragma unroll
                    for (int n = 0; n < 2; ++n)
#pragma unroll
                        for (int e = 0; e < 4; ++e) { const float p = ex2(acc[ai][bj][m][n][e] - mx); acc[ai][bj][m][n][e] = p; s += p; }
                s += shx(s, 16); s += shx(s, 32);
                X[(ai * HALF + wr * 64 + m * 16 + fr) * 4 + wc] = (f32x2){mx, s}; }
        LDS_WAIT(); __builtin_amdgcn_s_barrier(); asm volatile("" ::: "memory");
        const size_t row0 = (size_t)u.pm * BM + wr * 64 + fr; const int col0 = u.pn * BM + wc * 32 + 8 * fq;
#pragma unroll
        for (int ai = 0; ai < 2; ++ai)
#pragma unroll
            for (int m = 0; m < 4; ++m) { const int r = ai * HALF + wr * 64 + m * 16 + fr;
                asm volatile("" ::: "memory");
                const f32x2 a = X[r * 4 + 0], b = X[r * 4 + 1], c = X[r * 4 + 2], d = X[r * 4 + 3];
                const float M = fmaxf(fmaxf(a.x, b.x), fmaxf(c.x, d.x));
                const float Lsum = a.y * ex2(a.x - M) + b.y * ex2(b.x - M) + c.y * ex2(c.x - M) + d.y * ex2(d.x - M);
                const float mine = wc == 0 ? a.x : (wc == 1 ? b.x : (wc == 2 ? c.x : d.x));
                const float f = ex2(mine - M) * rcp(Lsum);
                bf16_t* rowp = P + (row0 + ai * HALF + m * 16) * 1024 + col0;
#pragma unroll
                for (int bj = 0; bj < 2; ++bj) { const f32x4 v0 = acc[ai][bj][m][0] * f, v1 = acc[ai][bj][m][1] * f;
                    u32x4 w; w.x = cvt_pk_bf16(v0[0], v0[1]); w.y = cvt_pk_bf16(v0[2], v0[3]); w.z = cvt_pk_bf16(v1[0], v1[1]); w.w = cvt_pk_bf16(v1[2], v1[3]);
                    *(u32x4*)(rowp + bj * HALF) = w; } }
        LDS_WAIT();
    }
};

struct EpiResid {
    static constexpr bool NEEDS_LDS = true, RS_PREFETCH = false;
    bf16_t* XB; const float* gpost; unsigned long long* SL; float* RS4; float* out_f32; unsigned tag; float eps;
    __device__ __forceinline__ static void reduce8(const float (&s)[8], float (&d)[2]) {
        float c[4];
#pragma unroll
        for (int j = 0; j < 4; ++j) { const auto r = __builtin_amdgcn_permlane32_swap(__float_as_uint(s[2 * j]), __float_as_uint(s[2 * j + 1]), false, false);
            c[j] = __uint_as_float(r[0]) + __uint_as_float(r[1]); }
#pragma unroll
        for (int k = 0; k < 2; ++k) { const auto r = __builtin_amdgcn_permlane16_swap(__float_as_uint(c[2 * k]), __float_as_uint(c[2 * k + 1]), false, false);
            d[k] = __uint_as_float(r[0]) + __uint_as_float(r[1]); }
    }
    __device__ __forceinline__ void operator()(f32x4 (&acc)[2][2][4][2], const Unit& u, int wr, int wc, int, int, LAS unsigned char* xl) const {
        const int tid_ = tid_of(wr * 4 + wc); const int fr = tid_ & 15, fq = (tid_ >> 4) & 3;
        LAS float* X = (LAS float*)xl; LAS float* RY = (LAS float*)(xl + 4096);
        const int lrow0 = wr * 64 + fr, t = wc * 64 + fq * 16 + fr;
        const int xoff = (lrow0 + (((fq & 1) << 1) | (fq >> 1)) * 16) * 4 + wc;
        { float s[8], d[2];
#pragma unroll
          for (int ai = 0; ai < 2; ++ai)
#pragma unroll
            for (int m = 0; m < 4; ++m) { float a = 0.f;
#pragma unroll
                for (int bj = 0; bj < 2; ++bj)
#pragma unroll
                    for (int n = 0; n < 2; ++n)
#pragma unroll
                        for (int e = 0; e < 4; ++e) a = fmaf(acc[ai][bj][m][n][e], acc[ai][bj][m][n][e], a);
                s[ai * 4 + m] = a; }
          reduce8(s, d); X[xoff] = d[0]; X[HALF * 4 + xoff] = d[1]; }
        LDS_WAIT(); __builtin_amdgcn_s_barrier(); asm volatile("" ::: "memory");
        unsigned long long* sl = SL + (size_t)u.pm * 1024 + t;
        if (wr == 0) { const f32x4 v = *(const LAS f32x4*)(X + t * 4); const float s = (v.x + v.y) + (v.z + v.w);
            __hip_atomic_store(sl + u.pn * 256, ((unsigned long long)tag << 32) | (unsigned long long)__builtin_bit_cast(unsigned, s), __ATOMIC_RELAXED, __HIP_MEMORY_SCOPE_AGENT); }
        const int col0 = u.pn * BM + wc * 32 + 8 * fq;
        const size_t tile0 = ((size_t)u.pm * BM + wr * 64) * D_ + u.pn * BM + wc * 32;
        const unsigned vo = (unsigned)(fr * D_ + 8 * fq);
        char* xt = (char*)(XB + tile0);
        u32x4 xw[2][4][2];
#define RESID_LDX(ai, m0, m1) do { _Pragma("unroll") for (int m = m0; m < m1; ++m) _Pragma("unroll") for (int bj = 0; bj < 2; ++bj) \
            xw[ai][m][bj] = *(const u32x4*)(xt + (size_t)(((ai) * HALF + m * 16) * D_ + bj * HALF) * 2 + vo * 2u); } while (0)
        RESID_LDX(0, 0, 4); RESID_LDX(1, 0, 3);
        if (wr == 0) { unsigned long long v0, v1, v2, v3; unsigned sp = 0;
            for (;;) { v0 = __hip_atomic_load(sl, __ATOMIC_RELAXED, __HIP_MEMORY_SCOPE_AGENT); v1 = __hip_atomic_load(sl + 256, __ATOMIC_RELAXED, __HIP_MEMORY_SCOPE_AGENT);
                v2 = __hip_atomic_load(sl + 512, __ATOMIC_RELAXED, __HIP_MEMORY_SCOPE_AGENT); v3 = __hip_atomic_load(sl + 768, __ATOMIC_RELAXED, __HIP_MEMORY_SCOPE_AGENT);
                if (((unsigned)(v0 >> 32) == tag) & ((unsigned)(v1 >> 32) == tag) & ((unsigned)(v2 >> 32) == tag) & ((unsigned)(v3 >> 32) == tag)) break;
                __builtin_amdgcn_s_sleep(1); if (++sp > (1u << 22)) break; }
            const float s = (__builtin_bit_cast(float, (unsigned)v0) + __builtin_bit_cast(float, (unsigned)v1)) + (__builtin_bit_cast(float, (unsigned)v2) + __builtin_bit_cast(float, (unsigned)v3));
            RY[t] = __builtin_amdgcn_rsqf(s * (1.f / D_) + eps); }
        LDS_WAIT(); __builtin_amdgcn_s_barrier(); asm volatile("" ::: "memory");
        RESID_LDX(1, 3, 4);
#undef RESID_LDX
        f32x4 g[2][2]; float sq[8];
#pragma unroll
        for (int bj = 0; bj < 2; ++bj) { g[bj][0] = *(const f32x4*)(gpost + col0 + bj * HALF); g[bj][1] = *(const f32x4*)(gpost + col0 + bj * HALF + 4); }
#pragma unroll
        for (int ai = 0; ai < 2; ++ai)
#pragma unroll
            for (int m = 0; m < 4; ++m) { const float ry = RY[ai * HALF + lrow0 + m * 16]; float s2 = 0.f;
#pragma unroll
                for (int bj = 0; bj < 2; ++bj) { const u32x4 w = xw[ai][m][bj];
                    f32x4 x0 = (f32x4){bflo(w.x), bfhi(w.x), bflo(w.y), bfhi(w.y)}, x1 = (f32x4){bflo(w.z), bfhi(w.z), bflo(w.w), bfhi(w.w)};
                    x0 = x0 + (acc[ai][bj][m][0] * ry) * g[bj][0]; x1 = x1 + (acc[ai][bj][m][1] * ry) * g[bj][1];
                    if (out_f32) { char* op = (char*)(out_f32 + tile0) + (size_t)((ai * HALF + m * 16) * D_ + bj * HALF) * 4 + vo * 4u; *(f32x4*)op = x0; *(f32x4*)(op + 16) = x1; }
                    else { s2 += ((x0.x * x0.x + x0.y * x0.y) + (x0.z * x0.z + x0.w * x0.w)) + ((x1.x * x1.x + x1.y * x1.y) + (x1.z * x1.z + x1.w * x1.w));
                        u32x4 o; o.x = cvt_pk_bf16(x0[0], x0[1]); o.y = cvt_pk_bf16(x0[2], x0[3]); o.z = cvt_pk_bf16(x1[0], x1[1]); o.w = cvt_pk_bf16(x1[2], x1[3]);
                        *(u32x4*)(xt + (size_t)((ai * HALF + m * 16) * D_ + bj * HALF) * 2 + vo * 2u) = o; } }
                sq[ai * 4 + m] = s2; }
        if (!out_f32) { float d[2]; reduce8(sq, d);
            const int tid2 = tid_of(wr * 4 + wc); const int fr2 = tid2 & 15, fq2 = (tid2 >> 4) & 3, t2 = wc * 64 + (tid2 & 63);
            const int xoff2 = (wr * 64 + fr2 + (((fq2 & 1) << 1) | (fq2 >> 1)) * 16) * 4 + wc;
            X[xoff2] = d[0]; X[HALF * 4 + xoff2] = d[1]; LDS_WAIT(); __builtin_amdgcn_s_barrier(); asm volatile("" ::: "memory");
            if (wr == 0) { const f32x4 v = *(const LAS f32x4*)(X + t2 * 4); RS4[((size_t)u.pm * BM + t2) * 4 + u.pn] = (v.x + v.y) + (v.z + v.w); } }
        LDS_WAIT();
    }
};

template <bool F8>
__device__ __forceinline__ void mma_step(f32x4& c, const bf16x8 (&b)[2], const bf16x8 (&a)[2], int sc) {
    if constexpr (F8) {
        const i32x8 B = __builtin_shufflevector(__builtin_bit_cast(i32x4, b[0]), __builtin_bit_cast(i32x4, b[1]), 0, 1, 2, 3, 4, 5, 6, 7);
        const i32x8 A = __builtin_shufflevector(__builtin_bit_cast(i32x4, a[0]), __builtin_bit_cast(i32x4, a[1]), 0, 1, 2, 3, 4, 5, 6, 7);
        c = __builtin_amdgcn_mfma_scale_f32_16x16x128_f8f6f4(B, A, c, 0, 0, 0, 0, 0, 0); (void)sc;
    } else {
        c = __builtin_amdgcn_mfma_f32_16x16x32_bf16(b[0], a[0], c, 0, 0, 0); c = __builtin_amdgcn_mfma_f32_16x16x32_bf16(b[1], a[1], c, 0, 0, 0);
    }
}
template <bool F8, class Epi, class Sched>
__device__ __forceinline__ void gemm_phase(LAS unsigned char* lds, LAS unsigned char* xl, const Gemm g, const Sched& S, const Epi& E, const int tid) {
    const int wid = __builtin_amdgcn_readfirstlane(tid >> 6), lane = tid & 63, wr = wid >> 2, wc = wid & 3, fr = lane & 15, fq = lane >> 4;
    int sc1 = 0x7f7f7f7f; asm volatile("" : "+s"(sc1));
    int nt = g.K / BK; asm volatile("" : "+s"(nt));
    unsigned voffA[2], voffB[2]; int aoff, boff;
#define PG8_LANE_SETUP() do { const int t_ = tid_of(wid); const int fr_ = t_ & 15, fq_ = (t_ >> 4) & 3; \
        _Pragma("unroll") for (int i = 0; i < 2; ++i) { int R, C; stage_rc(t_ * 16 + i * 8192, R, C); const int Rb = (R & ~31) + perm32(R & 31); \
            voffA[i] = (unsigned)(R * g.lda + C) * 2u; voffB[i] = (unsigned)(Rb * g.ldb + C) * 2u; } \
        aoff = lds_byte(wr * 64 + fr_, fq_ * 8); boff = lds_byte(wc * 32 + fr_, fq_ * 8); } while (0)
    PG8_LANE_SETUP();
    const unsigned kstep = (unsigned)(BK * 2);
    const unsigned hstepA = (unsigned)HALF * g.lda * 2u, hstepB = (unsigned)HALF * g.ldb * 2u;
    const __amdgpu_buffer_rsrc_t srdA = __builtin_amdgcn_make_buffer_rsrc((void*)g.A, 0, 0x7fffffff, 0x00020000), srdB = __builtin_amdgcn_make_buffer_rsrc((void*)g.Bt, 0, 0x7fffffff, 0x00020000);
    const unsigned ldsw = (unsigned)wid * 1024u;
#define PG8_SA(b, h) (((b) * 2 + (h)) * HTB)
#define PG8_SB(b, h) ((4 + (b) * 2 + (h)) * HTB)
#define PG8_STAGE(bufoff, srd, goff, voff) do { _Pragma("unroll") for (int _i = 0; _i < 2; ++_i) \
        __builtin_amdgcn_raw_ptr_buffer_load_lds(srd, (LAS unsigned*)(lds + (bufoff) + ldsw + _i * 8192), 16, (voff)[_i], (goff), 0, 0); } while (0)
#define PG8_LDA(dst, b, h) do { _Pragma("unroll") for (int m = 0; m < 4; ++m) _Pragma("unroll") for (int k = 0; k < 2; ++k) dst[m][k] = *(const LAS bf16x8*)(lds + PG8_SA(b, h) + aoff + m * 2048 + k * 1024); } while (0)
#define PG8_LDB(dst, b, h) do { _Pragma("unroll") for (int n = 0; n < 2; ++n) _Pragma("unroll") for (int k = 0; k < 2; ++k) dst[n][k] = *(const LAS bf16x8*)(lds + PG8_SB(b, h) + boff + n * 2048 + k * 1024); } while (0)
#define PG8_MMA(ai, bj, At, Bt) do { __builtin_amdgcn_s_setprio(1); _Pragma("unroll") for (int m = 0; m < 4; ++m) _Pragma("unroll") for (int n = 0; n < 2; ++n) \
        mma_step<F8>(acc[ai][bj][m][n], Bt[n], At[m], sc1); __builtin_amdgcn_s_setprio(0); } while (0)
#define PG8_WAIT_V(n) asm volatile("s_waitcnt vmcnt(" #n ")" ::: "memory")
#define PG8_WAIT_L(n) asm volatile("s_waitcnt lgkmcnt(" #n ")" ::: "memory")
#define PG8_BAR __builtin_amdgcn_s_barrier()
#define PG8_SCHED __builtin_amdgcn_sched_barrier(0)
    Unit cur, nxt; int ui = 0;
    if (!S.next(0, cur)) return;
#define PG8_RSLOAD(u_, par_) do { if constexpr (Epi::RS_PREFETCH) { if (wid < 4) __builtin_amdgcn_raw_ptr_buffer_load_lds(srdR, (LAS unsigned*)(xl + (par_) * 4096 + wid * 1024), 16, \
        (unsigned)(tid_of(wid) & 63) * 16u, (unsigned)((u_).pm * BM + wid * 64) * 16u, 0, 0); } } while (0)
    __amdgpu_buffer_rsrc_t srdR; if constexpr (Epi::RS_PREFETCH) srdR = __builtin_amdgcn_make_buffer_rsrc((void*)E.rs, 0, 0x7fffffff, 0x00020000);
    PG8_RSLOAD(cur, 0);
    f32x4 acc[2][2][4][2];
#pragma unroll
    for (int a = 0; a < 2; ++a)
#pragma unroll
        for (int b = 0; b < 2; ++b)
#pragma unroll
            for (int m = 0; m < 4; ++m)
#pragma unroll
                for (int n = 0; n < 2; ++n) acc[a][b][m][n] = (f32x4){0.f, 0.f, 0.f, 0.f};
    bf16x8 At[4][2], B0[2][2], B1[2][2];
    unsigned cA = (unsigned)cur.aoff, cB = (unsigned)cur.boff;
    PG8_STAGE(PG8_SB(0, 0), srdB, cB, voffB); PG8_STAGE(PG8_SB(0, 1), srdB, cB + hstepB, voffB); PG8_STAGE(PG8_SA(0, 0), srdA, cA, voffA); PG8_STAGE(PG8_SA(0, 1), srdA, cA + hstepA, voffA);
    if (wr == 1) PG8_BAR;
    PG8_WAIT_V(2); PG8_BAR;
    PG8_STAGE(PG8_SB(1, 0), srdB, cB + kstep, voffB); PG8_STAGE(PG8_SA(1, 0), srdA, cA + kstep, voffA); PG8_STAGE(PG8_SB(1, 1), srdB, cB + hstepB + kstep, voffB);
    PG8_WAIT_V(6); PG8_BAR;
    for (;;) {
        const bool has_next = S.next(ui + 1, nxt);
        const unsigned nA = has_next ? (unsigned)nxt.aoff : cA, nB = has_next ? (unsigned)nxt.boff : cB;
        for (int t = 0; t < nt; t += 2) {
            const bool last = (t == nt - 2);
            const unsigned a1 = cA + (unsigned)(t + 1) * kstep;
            const unsigned a2 = last ? nA : cA + (unsigned)(t + 2) * kstep, b2 = last ? nB : cB + (unsigned)(t + 2) * kstep;
            const unsigned a3 = a2 + kstep, b3 = b2 + kstep;
            PG8_LDB(B0, 0, 0); PG8_LDB(B1, 0, 1); PG8_SCHED; PG8_LDA(At, 0, 0); PG8_STAGE(PG8_SA(1, 1), srdA, a1 + hstepA, voffA);
            PG8_WAIT_V(8); PG8_WAIT_L(0); PG8_BAR; PG8_MMA(0, 0, At, B0); PG8_MMA(0, 1, At, B1); PG8_BAR; PG8_SCHED;
            PG8_LDA(At, 0, 1); PG8_STAGE(PG8_SB(0, 0), srdB, b2, voffB); PG8_STAGE(PG8_SB(0, 1), srdB, b2 + hstepB, voffB); PG8_STAGE(PG8_SA(0, 0), srdA, a2, voffA);
            PG8_WAIT_V(8); PG8_WAIT_L(0); PG8_BAR; PG8_MMA(1, 0, At, B0); PG8_MMA(1, 1, At, B1); PG8_BAR; PG8_SCHED;
            PG8_LDB(B0, 1, 0); PG8_LDB(B1, 1, 1); PG8_SCHED; PG8_LDA(At, 1, 0); PG8_STAGE(PG8_SA(0, 1), srdA, a2 + hstepA, voffA);
            PG8_WAIT_V(8); PG8_WAIT_L(0); PG8_BAR; PG8_MMA(0, 0, At, B0); PG8_MMA(0, 1, At, B1); PG8_BAR; PG8_SCHED;
            PG8_LDA(At, 1, 1); PG8_STAGE(PG8_SB(1, 0), srdB, b3, voffB); PG8_STAGE(PG8_SB(1, 1), srdB, b3 + hstepB, voffB); PG8_STAGE(PG8_SA(1, 0), srdA, a3, voffA);
            PG8_WAIT_V(8); PG8_WAIT_L(0); PG8_BAR; PG8_MMA(1, 0, At, B0); PG8_MMA(1, 1, At, B1); PG8_BAR; PG8_SCHED;
        }
        if (wr == 0) PG8_BAR;
        E(acc, cur, wr, wc, fr, fq, Epi::RS_PREFETCH ? xl + (ui & 1) * 4096 : xl);
        if (!has_next) break;
#pragma unroll
        for (int a = 0; a < 2; ++a)
#pragma unroll
            for (int b = 0; b < 2; ++b)
#pragma unroll
                for (int m = 0; m < 4; ++m)
#pragma unroll
                    for (int n = 0; n < 2; ++n) acc[a][b][m][n] = (f32x4){0.f, 0.f, 0.f, 0.f};
        cur = nxt; cA = nA; cB = nB; ++ui;
        PG8_RSLOAD(cur, ui & 1);
        PG8_LANE_SETUP();
        if (wr == 1) PG8_BAR;
    }
    PG8_WAIT_V(0);
    PG8_BAR;
#undef PG8_LANE_SETUP
#undef PG8_RSLOAD
#undef PG8_SA
#undef PG8_SB
#undef PG8_STAGE
#undef PG8_LDA
#undef PG8_LDB
#undef PG8_MMA
#undef PG8_WAIT_V
#undef PG8_WAIT_L
#undef PG8_BAR
#undef PG8_SCHED
}
}

struct Args { const float* in[30]; float* out; unsigned char* ws; int ph_lo, ph_hi; };
enum { I_X = 0, I_MEM, I_RELB, I_LN_MIX_PRE, I_LN_MIX_POST, I_W_IN, I_PE_K, I_PE_V, I_CW_K, I_CW_V, I_CONV_W, I_CONV_B, I_LRU_WA, I_LRU_BA, I_LRU_WX, I_LRU_BX, I_LRU_LAM,
       I_GN_ATTN, I_GN_LRU, I_W_OUT, I_LN_X_PRE, I_LN_X_POST, I_LN_MEM, I_XQ, I_XKV, I_XO, I_LN_MLP_PRE, I_LN_MLP_POST, I_W1, I_W2 };

__device__ __forceinline__ void tr_item(const float* W, long ldw, bool kperm, bf16_t* WT, long ldt, int k0, int n0, int srccol, float nscale, const float* gain, LAS float* scr, int lane, bool f8 = false) {
    const int kr = lane >> 4, nq = lane & 15;
#pragma unroll 8
    for (int i = 0; i < 16; ++i) { const int kk = 4 * i + kr; const int k = k0 + kk; const long srow = kperm ? (long)((k & 63) * 64 + (k >> 6)) : (long)k;
        f32x4 v = {0.f, 0.f, 0.f, 0.f}; if (srccol >= 0) v = *(const f32x4*)(W + srow * ldw + srccol); float gs = nscale; if (gain) gs *= gain[k]; v *= gs;
        LAS float* d = scr + kk * 65 + 4 * nq; d[0] = v.x; d[1] = v.y; d[2] = v.z; d[3] = v.w; }
    LDS_WAIT(); asm volatile("" ::: "memory");
    const int c = lane & 7;
#pragma unroll
    for (int j = 0; j < 8; ++j) { const int n = (lane >> 3) + 8 * j; const LAS float* sp = scr + (8 * c) * 65 + n;
        if (f8) { int p0 = __builtin_amdgcn_cvt_pk_fp8_f32(sp[0 * 65], sp[1 * 65], 0, false); p0 = __builtin_amdgcn_cvt_pk_fp8_f32(sp[2 * 65], sp[3 * 65], p0, true);
            int p1 = __builtin_amdgcn_cvt_pk_fp8_f32(sp[4 * 65], sp[5 * 65], 0, false); p1 = __builtin_amdgcn_cvt_pk_fp8_f32(sp[6 * 65], sp[7 * 65], p1, true);
            *(u32x2*)((unsigned char*)WT + (size_t)(n0 + n) * ldt + k0 + 8 * c) = (u32x2){(unsigned)p0, (unsigned)p1}; continue; }
        u32x4 o; o.x = pk2(sp[0 * 65], sp[1 * 65]); o.y = pk2(sp[2 * 65], sp[3 * 65]); o.z = pk2(sp[4 * 65], sp[5 * 65]); o.w = pk2(sp[6 * 65], sp[7 * 65]);
        *(u32x4*)(WT + (size_t)(n0 + n) * ldt + k0 + 8 * c) = o; }
    LDS_WAIT(); asm volatile("" ::: "memory");
}
__device__ __forceinline__ int wina_srccol(int n) {
    if (n < 512) return n;
    if (n < 640) return n;
    if (n < 768) return 768 + (n - 640);
    if (n < 896) return 1024 + (n - 768);
    if (n < 920) return 1280 + (n - 896);
    if (n < 1024) return -1;
    if (n < 1536) return 1304 + (n - 1024);
    return 1816 + (n - 1536);
}
__device__ __forceinline__ int winv_srccol(int n) {
    if (n < 128) return 640 + n;
    if (n < 256) return 896 + (n - 128);
    if (n < 384) return 1152 + (n - 256);
    return -1;
}
__device__ __forceinline__ void norm_row_to_bf16(const float* xrow, bf16_t* orow, int lane) {
    const f32x4* xr = (const f32x4*)xrow + lane; f32x4 v[4]; float s = 0.f;
#pragma unroll
    for (int j = 0; j < 4; ++j) { v[j] = xr[64 * j]; s += (v[j].x * v[j].x + v[j].y * v[j].y) + (v[j].z * v[j].z + v[j].w * v[j].w); }
    const float r = 1.0f / sqrtf(wave_sum(s) * (1.f / D_) + EPS_);
    u32x2* o8 = (u32x2*)orow + lane;
#pragma unroll
    for (int j = 0; j < 4; ++j) { u32x2 w; w.x = pk2(v[j].x * r, v[j].y * r); w.y = pk2(v[j].z * r, v[j].w * r); o8[64 * j] = w; }
}
__device__ __forceinline__ void prologue_phase(const Args& A, LAS unsigned char* lds, int tid, int wave, int lane) {
    LAS float* scr = (LAS float*)(lds + wave * 17408);
    const int gw = blockIdx.x * 8 + wave, NGW = gridDim.x * 8;
    constexpr int C0 = 512, C1 = C0 + 128, C2 = C1 + 256, C3 = C2 + 256, C4 = C3 + 256, C5 = C4 + 256, C6 = C5 + 256, C7 = C6 + 1024, C8 = C7 + 1024, C9 = C8 + 64, C10 = C9 + 64, C11 = C10 + 8, C12 = C11 + 8;
    for (int it = gw; it < NL_ * C12; it += NGW) {
        const int l = it / C12; int r = it % C12;
        unsigned char* wl = A.ws + WS_W + (size_t)l * WL_STRIDE;
        const int nl = 4 * (lane & 15);
        if (r < C0) { const int kb = r / 32, nb = r % 32; const int n = nb * 64 + nl;
            tr_item(A.in[I_W_IN] + (size_t)l * D_ * INC_, INC_, false, (bf16_t*)(wl + W_INA), D_, kb * 64, nb * 64, wina_srccol(n), n < 512 ? C2_ : 1.0f, A.in[I_LN_MIX_PRE] + l * D_, scr, lane); continue; }
        if (r < C1) { r -= C0; const int kb = r / 8, nb = r % 8; const int n = nb * 64 + nl;
            tr_item(A.in[I_W_IN] + (size_t)l * D_ * INC_, INC_, false, (bf16_t*)(wl + W_INV), D_, kb * 64, nb * 64, winv_srccol(n), 1.0f, A.in[I_LN_MIX_PRE] + l * D_, scr, lane); continue; }
        if (r < C2) { r -= C1; const int kb = r / 16, nb = r % 16;
            const float* gain = (kb < 8) ? A.in[I_GN_ATTN] + l * 512 : A.in[I_GN_LRU] + l * 512 - 512;
            tr_item(A.in[I_W_OUT] + (size_t)l * D_ * D_, D_, false, (bf16_t*)(wl + W_OUT), D_, kb * 64, nb * 64, nb * 64 + nl, 1.0f, gain, scr, lane); continue; }
        if (r < C3) { r -= C2; const int kb = r / 16, nb = r % 16;
            tr_item(A.in[I_XQ] + (size_t)l * D_ * D_, D_, false, (bf16_t*)(wl + W_XQ), D_, kb * 64, nb * 64, nb * 64 + nl, XC2_, A.in[I_LN_X_PRE] + l * D_, scr, lane); continue; }
        if (r < C4) { r -= C3; const int kb = r / 16, nb = r % 16;
            tr_item(A.in[I_XKV] + (size_t)l * D_ * 2 * D_, 2 * D_, false, (bf16_t*)(wl + W_XK), D_, kb * 64, nb * 64, nb * 64 + nl, 1.0f, A.in[I_LN_MEM] + l * D_, scr, lane); continue; }
        if (r < C5) { r -= C4; const int kb = r / 16, nb = r % 16;
            tr_item(A.in[I_XKV] + (size_t)l * D_ * 2 * D_, 2 * D_, false, (bf16_t*)(wl + W_XV), D_, kb * 64, nb * 64, 1024 + nb * 64 + nl, 1.0f, A.in[I_LN_MEM] + l * D_, scr, lane); continue; }
        if (r < C6) { r -= C5; const int kb = r / 16, nb = r % 16;
            tr_item(A.in[I_XO] + (size_t)l * D_ * D_, D_, false, (bf16_t*)(wl + W_XO), D_, kb * 64, nb * 64, nb * 64 + nl, 1.0f, nullptr, scr, lane); continue; }
        if (r < C7) { r -= C6; const int kb = r / 64, nb = r % 64;
            tr_item(A.in[I_W1] + (size_t)l * D_ * FF_, FF_, false, (bf16_t*)(wl + W_1), D_, kb * 64, nb * 64, nb * 64 + nl, 1.0f, A.in[I_LN_MLP_PRE] + l * D_, scr, lane); continue; }
        if (r < C8) { r -= C7; const int kb = r / 16, nb = r % 16;
            tr_item(A.in[I_W2] + (size_t)l * FF_ * D_, D_, false, (bf16_t*)(wl + W_2), FF_, kb * 64, nb * 64, nb * 64 + nl, W8_SCALE, nullptr, scr, lane, true); continue; }
        if (r < C10) { r -= C8; const int isv = r >> 6; r &= 63;
            const float* W = A.in[isv ? I_CW_V : I_CW_K] + (size_t)l * 4096 * 64; bf16_t* WF = (bf16_t*)(wl + (isv ? W_CV : W_CK)); const float* pe = A.in[isv ? I_PE_V : I_PE_K] + l * 4096;
            const int kr = lane >> 4, nq = lane & 15; f32x4 pacc = {0.f, 0.f, 0.f, 0.f};
#pragma unroll 8
            for (int i = 0; i < 16; ++i) { const int kk = 4 * i + kr; const int srck = isv ? (kk * 64 + r) : (r * 64 + kk);
                const f32x4 v = *(const f32x4*)(W + (size_t)srck * 64 + 4 * nq); pacc += v * pe[srck];
                LAS float* d = scr + kk * 65 + 4 * nq; d[0] = v.x; d[1] = v.y; d[2] = v.z; d[3] = v.w; }
#pragma unroll
            for (int cc = 0; cc < 4; ++cc) { pacc[cc] += shx(pacc[cc], 16); pacc[cc] += shx(pacc[cc], 32); }
            if (lane < 16) *(f32x4*)((float*)(A.ws + WS_PEP) + (size_t)((l * 2 + isv) * 64 + r) * 64 + 4 * nq) = pacc;
            LDS_WAIT(); asm volatile("" ::: "memory");
            const int r32 = lane & 31, hi = lane >> 5;
#pragma unroll
            for (int c8 = 0; c8 < 8; ++c8) { const int ksl = c8 >> 1, half = c8 & 1; const LAS float* sp = scr + (ksl * 16 + 8 * hi) * 65 + half * 32 + r32;
                u32x4 w; w.x = pk2(sp[0 * 65], sp[1 * 65]); w.y = pk2(sp[2 * 65], sp[3 * 65]); w.z = pk2(sp[4 * 65], sp[5 * 65]); w.w = pk2(sp[6 * 65], sp[7 * 65]);
                *(u32x4*)(WF + ((size_t)((r * 4 + ksl) * 2 + half) * 64 + lane) * 8) = w; }
            LDS_WAIT(); asm volatile("" ::: "memory");
            continue; }
        if (r < C11) { r -= C10;
            tr_item(A.in[I_LRU_WA] + (size_t)(l * 8 + r) * 4096, 64, false, (bf16_t*)(wl + W_A) + r * 4096, 64, 0, 0, nl, 1.0f, nullptr, scr, lane); continue; }
        { r -= C11;
            tr_item(A.in[I_LRU_WX] + (size_t)(l * 8 + r) * 4096, 64, false, (bf16_t*)(wl + W_X) + r * 4096, 64, 0, 0, nl, 1.0f, nullptr, scr, lane); }
    }
    for (int m = gw; m < T_; m += NGW) {
        const f32x4* xr = (const f32x4*)(A.in[I_X] + (size_t)m * D_) + lane; f32x4 v[4]; float sq = 0.f;
#pragma unroll
        for (int j = 0; j < 4; ++j) { v[j] = xr[64 * j]; sq += (v[j].x * v[j].x + v[j].y * v[j].y) + (v[j].z * v[j].z + v[j].w * v[j].w); }
        sq = wave_sum(sq); if (lane == 0) ((f32x4*)(A.ws + WS_RS))[m] = (f32x4){sq, 0.f, 0.f, 0.f};
        u32x2* o8 = (u32x2*)((bf16_t*)(A.ws + WS_HB) + (size_t)m * D_) + lane;
#pragma unroll
        for (int j = 0; j < 4; ++j) { u32x2 w; w.x = pk2(v[j].x, v[j].y); w.y = pk2(v[j].z, v[j].w); o8[64 * j] = w; } }
    for (int m = gw; m < NB_ * MEM_; m += NGW) norm_row_to_bf16(A.in[I_MEM] + (size_t)m * D_, (bf16_t*)(A.ws + WS_MNB) + (size_t)m * D_, lane);
    { unsigned z = 0u; asm volatile("" : "+v"(z));
      for (int i = blockIdx.x * NTHREADS + tid; i < 128 * 4 * 256; i += gridDim.x * NTHREADS) ((u32x2*)(A.ws + WS_SLOT))[i] = (u32x2){z, z};
      for (int i = blockIdx.x * NTHREADS + tid; i < NL_ * 512 * 512; i += gridDim.x * NTHREADS) ((u32x2*)(A.ws + WS_AGG2))[i] = (u32x2){z, z}; }
}

__device__ __forceinline__ void compress_item(const Args& A, int l, int item, LAS unsigned char* lds, int wave) {
    const int tid = tid_of(wave); const int lane = tid & 63;
    const int which = item >> 6, rt = (item >> 1) & 31, half = item & 1;
    const int r32 = lane & 31, hi = lane >> 5;
    const int row = rt * 32 + r32;
    const int g = row >> 9, b = (row >> 7) & 3, n = row & 127;
    const bf16_t* Wf = (const bf16_t*)(A.ws + WS_W + (size_t)l * WL_STRIDE + (which ? W_CV : W_CK)) + ((size_t)((wave * 32) * 2 + half) * 64 + lane) * 8;
    const bf16_t* Ak = (const bf16_t*)(A.ws + WS_KP) + ((size_t)g * T_ + (size_t)b * S_ + n * 64) * 64 + wave * 512 + 8 * hi;
    const bf16_t* Av = (const bf16_t*)(A.ws + WS_VT) + (size_t)(g * 64 + wave * 8) * T_ + (size_t)b * S_ + n * 64 + 8 * hi;
    float bp = 0.f;
    { const float* pp = (const float*)(A.ws + WS_PEP) + (size_t)((l * 2 + which) * 64 + wave * 8) * 64 + lane;
#pragma unroll
      for (int i = 0; i < 8; ++i) bp += pp[i * 64]; }
    f32x16 c0 = {};
#pragma unroll 8
    for (int ks = 0; ks < 32; ++ks) {
        const bf16x8 af = which ? *(const bf16x8*)(Av + (size_t)(ks >> 2) * T_ + (ks & 3) * 16) : *(const bf16x8*)(Ak + ks * 16);
        const bf16x8 b0 = *(const bf16x8*)(Wf + ks * 1024);
        c0 = __builtin_amdgcn_mfma_f32_32x32x16_bf16(af, b0, c0, 0, 0, 0); }
    LAS float* red = (LAS float*)lds + wave * 1024;
#pragma unroll
    for (int r = 0; r < 16; ++r) red[crow(r, hi) * 32 + r32] = c0[r];
    ((LAS float*)lds)[8 * 1024 + tid] = bp;
    __syncthreads();
    { const int orow = rt * 32 + (tid >> 4), e0 = half * 32 + (tid & 15) * 2;
      float s0 = 0.f, s1 = 0.f;
#pragma unroll
      for (int w = 0; w < 8; ++w) { s0 += ((LAS float*)lds)[8 * 1024 + w * 64 + e0]; s1 += ((LAS float*)lds)[8 * 1024 + w * 64 + e0 + 1]; }
#pragma unroll
      for (int w = 0; w < 8; ++w) { const f32x2 v = *(const LAS f32x2*)((LAS float*)lds + w * 1024 + tid * 2); s0 += v.x; s1 += v.y; }
      if (which == 0) *(unsigned*)((bf16_t*)(A.ws + WS_KCB) + (size_t)orow * 64 + e0) = pk2(s0, s1);
      else { bf16_t* vct = (bf16_t*)(A.ws + WS_VCT) + (size_t)(orow >> 7) * 8192 + (orow & 127); vct[(e0 + 0) * 128] = (bf16_t)f2bf(s0); vct[(e0 + 1) * 128] = (bf16_t)f2bf(s1); } }
    __syncthreads();
}

constexpr int LRU_WREG = 17408;
constexpr int LRU_XSS = 8 * LRU_WREG, LRU_CARRY = LRU_XSS + 2048;
__device__ __forceinline__ float one_minus_exp(float x) {
    float p = 1.0f + x * (1.0f / 6.0f); p = 1.0f + x * 0.2f * p; p = 1.0f + x * 0.25f * p; p = 1.0f + x * (1.0f / 3.0f) * p; p = 1.0f + x * 0.5f * p; return -x * p;
}
template <int PASS>
__device__ __forceinline__ void lru_item(const Args& A, int l, int b, int chunk, LAS unsigned char* lds, int wave) {
    const int tid = tid_of(wave); const int lane = tid & 63;
    const int n = wave, r32 = lane & 31, hi = lane >> 5;
    const size_t R0 = (size_t)b * S_ + (size_t)chunk * 64; const int t0 = chunk * 64;
    const bf16_t* XR = (const bf16_t*)(A.ws + WS_XR);
    float* AGG = (float*)(A.ws + WS_AGG);
    LAS unsigned char* wreg = lds + wave * LRU_WREG;
    u32x4 tv[9]; float wv[5];
    { const int c8 = lane & 7;
#pragma unroll
      for (int i = 0; i < 9; ++i) { const int rr = (lane >> 3) + 8 * i; const int tt = t0 + rr - 3; const bool ok = (rr < 67) && (tt >= 0);
          const long dr = ok ? (long)(rr - 3) : 0; const u32x4 v = *(const u32x4*)(XR + (R0 + dr) * 512 + n * 64 + c8 * 8); tv[i] = ok ? v : (u32x4){0u, 0u, 0u, 0u}; }
#pragma unroll
      for (int j = 0; j < 4; ++j) wv[j] = A.in[I_CONV_W][l * 2048 + j * 512 + n * 64 + lane];
      wv[4] = A.in[I_CONV_B][l * 512 + n * 64 + lane]; }
    if (PASS == 2) {
        const float* ag = AGG + (size_t)(b * 128) * 1024 + tid; float H = 0.f; int c = 0;
        for (; c + 16 <= chunk; c += 16) { float a_[16], b_[16];
#pragma unroll
            for (int q = 0; q < 16; ++q) { a_[q] = ag[(size_t)(c + q) * 1024]; b_[q] = ag[(size_t)(c + q) * 1024 + 512]; }
#pragma unroll
            for (int q = 0; q < 16; ++q) H = a_[q] * H + b_[q]; }
        for (; c < chunk; ++c) H = ag[(size_t)c * 1024] * H + ag[(size_t)c * 1024 + 512];
        ((LAS float*)(lds + LRU_CARRY))[tid] = H;
    }
    { const int c8 = lane & 7;
#pragma unroll
      for (int i = 0; i < 9; ++i) { const int rr = (lane >> 3) + 8 * i; if (rr < 67) *(LAS u32x4*)(wreg + rr * 144 + c8 * 16) = tv[i]; }
      LAS float* wl_ = (LAS float*)(wreg + 9728);
#pragma unroll
      for (int j = 0; j < 5; ++j) wl_[j * 64 + lane] = wv[j]; }
    LDS_WAIT(); asm volatile("" ::: "memory");
    bf16x8 xa[2][4];
    { const LAS float* wl_ = (const LAS float*)(wreg + 9728);
#pragma unroll
      for (int ks = 0; ks < 4; ++ks) { const int cl0 = 16 * ks + 8 * hi;
          f32x4 w0[4], w1[4];
#pragma unroll
          for (int j = 0; j < 4; ++j) { w0[j] = *(const LAS f32x4*)(wl_ + j * 64 + cl0); w1[j] = *(const LAS f32x4*)(wl_ + j * 64 + cl0 + 4); }
          const f32x4 b0 = *(const LAS f32x4*)(wl_ + 256 + cl0), b1 = *(const LAS f32x4*)(wl_ + 256 + cl0 + 4);
#pragma unroll
          for (int mt = 0; mt < 2; ++mt) { f32x4 a0 = b0, a1 = b1;
#pragma unroll
              for (int j = 0; j < 4; ++j) { const u32x4 v = *(const LAS u32x4*)(wreg + (32 * mt + r32 + j) * 144 + cl0 * 2);
                  a0 += w0[j] * (f32x4){bflo(v.x), bfhi(v.x), bflo(v.y), bfhi(v.y)}; a1 += w1[j] * (f32x4){bflo(v.z), bfhi(v.z), bflo(v.w), bfhi(v.w)}; }
              u32x4 pw; pw.x = pk2(a0.x, a0.y); pw.y = pk2(a0.z, a0.w); pw.z = pk2(a1.x, a1.y); pw.w = pk2(a1.z, a1.w);
              xa[mt][ks] = __builtin_bit_cast(bf16x8, pw); } } }
    if (PASS == 2) __syncthreads();
    else { LDS_WAIT(); asm volatile("" ::: "memory"); }
    const bf16_t* Wa = (const bf16_t*)(A.ws + WS_W + (size_t)l * WL_STRIDE + W_A) + n * 4096;
    const bf16_t* Wx = (const bf16_t*)(A.ws + WS_W + (size_t)l * WL_STRIDE + W_X) + n * 4096;
    LAS float* stage = (LAS float*)wreg;
#pragma unroll 1
    for (int nt = 0; nt < 2; ++nt) {
        const int e = 32 * nt + r32, ch = n * 64 + e;
        f32x16 Rr[2] = {}, Ii[2] = {}, Xc[2] = {};
#pragma unroll
        for (int ks = 0; ks < 4; ++ks) {
            const bf16x8 wa = *(const bf16x8*)(Wa + e * 64 + 16 * ks + 8 * hi), wx = *(const bf16x8*)(Wx + e * 64 + 16 * ks + 8 * hi);
            bf16x8 idf;
#pragma unroll
            for (int j = 0; j < 8; ++j) idf[j] = (16 * ks + 8 * hi + j == e) ? (short)0x3F80 : (short)0;
#pragma unroll
            for (int mt = 0; mt < 2; ++mt) {
                Rr[mt] = __builtin_amdgcn_mfma_f32_32x32x16_bf16(xa[mt][ks], wa, Rr[mt], 0, 0, 0);
                Ii[mt] = __builtin_amdgcn_mfma_f32_32x32x16_bf16(xa[mt][ks], wx, Ii[mt], 0, 0, 0);
                Xc[mt] = __builtin_amdgcn_mfma_f32_32x32x16_bf16(xa[mt][ks], idf, Xc[mt], 0, 0, 0); } }
        const float nba = -LOG2E_ * A.in[I_LRU_BA][l * 512 + ch], nbx = -LOG2E_ * A.in[I_LRU_BX][l * 512 + ch], lam = A.in[I_LRU_LAM][l * 512 + ch];
        const float cl2 = -8.0f * log1pf(expf(-lam)) * LOG2E_;
#pragma unroll
        for (int mt = 0; mt < 2; ++mt)
#pragma unroll
            for (int r = 0; r < 16; ++r) { const float rg = rcp(1.0f + ex2(__builtin_fmaf(Rr[mt][r], -LOG2E_, nba))), ig = rcp(1.0f + ex2(__builtin_fmaf(Ii[mt][r], -LOG2E_, nbx))); const float av = ex2(cl2 * rg);
                Rr[mt][r] = av; Ii[mt][r] = __builtin_amdgcn_sqrtf(__builtin_fmaf(-av, av, 1.0f)) * (ig * Xc[mt][r]); }
        float GA[8], GB[8];
#pragma unroll
        for (int gi = 0; gi < 8; ++gi) { const int mt = gi >> 2, i = gi & 3; float a = 1.f, bq = 0.f;
#pragma unroll
            for (int j = 0; j < 4; ++j) { const float aa = Rr[mt][4 * i + j]; bq = aa * bq + Ii[mt][4 * i + j]; a *= aa; }
            GA[gi] = a; GB[gi] = bq; }
        float H = 0.f;
        if (PASS == 2) H = ((const LAS float*)(lds + LRU_CARRY))[ch];
        float Hin[8]; float Atot = 1.f;
#pragma unroll
        for (int gi = 0; gi < 8; ++gi) {
            const auto ra = __builtin_amdgcn_permlane32_swap(__float_as_uint(GA[gi]), __float_as_uint(GA[gi]), false, false); const auto rb = __builtin_amdgcn_permlane32_swap(__float_as_uint(GB[gi]), __float_as_uint(GB[gi]), false, false);
            const float A0 = __uint_as_float(ra[0]), A1 = __uint_as_float(ra[1]), B0 = __uint_as_float(rb[0]), B1 = __uint_as_float(rb[1]);
            const float h0 = H; H = A0 * H + B0; const float h1 = H; H = A1 * H + B1; Hin[gi] = hi ? h1 : h0; Atot *= A0 * A1; }
        if (PASS == 1) { if (hi == 0) { float* ag = AGG + (size_t)(b * 128 + chunk) * 1024 + ch; ag[0] = Atot; ag[512] = H; } }
        else {
#pragma unroll
            for (int gi = 0; gi < 8; ++gi) { const int mt = gi >> 2, i = gi & 3; float h = Hin[gi];
#pragma unroll
                for (int j = 0; j < 4; ++j) { h = Rr[mt][4 * i + j] * h + Ii[mt][4 * i + j]; stage[(32 * mt + 8 * i + 4 * hi + j) * 68 + e] = h; } }
        }
    }
    if (PASS == 2) {
        LDS_WAIT(); asm volatile("" ::: "memory");
        const bf16_t* YG = (const bf16_t*)(A.ws + WS_YG); bf16_t* AB = (bf16_t*)(A.ws + WS_AB);
        LAS float* xss = (LAS float*)(lds + LRU_XSS);
        f32x4 v[8][2];
#pragma unroll
        for (int it = 0; it < 8; ++it) { const int row = it * 8 + (lane >> 3), c8 = lane & 7;
            if ((it & 1) == 0) asm volatile("" ::: "memory");
            const f32x4 h0 = *(const LAS f32x4*)(stage + row * 68 + c8 * 8), h1 = *(const LAS f32x4*)(stage + row * 68 + c8 * 8 + 4);
            const u32x4 y = *(const u32x4*)(YG + (R0 + row) * 512 + n * 64 + c8 * 8);
            v[it][0] = h0 * (f32x4){bflo(y.x), bfhi(y.x), bflo(y.y), bfhi(y.y)}; v[it][1] = h1 * (f32x4){bflo(y.z), bfhi(y.z), bflo(y.w), bfhi(y.w)};
            float ss = (v[it][0].x * v[it][0].x + v[it][0].y * v[it][0].y) + (v[it][0].z * v[it][0].z + v[it][0].w * v[it][0].w)
                     + (v[it][1].x * v[it][1].x + v[it][1].y * v[it][1].y) + (v[it][1].z * v[it][1].z + v[it][1].w * v[it][1].w);
            ss += __uint_as_float(__builtin_amdgcn_update_dpp(0u, __float_as_uint(ss), 0xB1, 0xF, 0xF, false)); ss += __uint_as_float(__builtin_amdgcn_update_dpp(0u, __float_as_uint(ss), 0x4E, 0xF, 0xF, false)); ss += __uint_as_float(__builtin_amdgcn_update_dpp(0u, __float_as_uint(ss), 0x141, 0xF, 0xF, false));
            if (c8 == 0) xss[wave * 64 + row] = ss; }
        __syncthreads();
#pragma unroll
        for (int it = 0; it < 8; ++it) { const int row = it * 8 + (lane >> 3), c8 = lane & 7; float tot = 0.f;
#pragma unroll
            for (int w = 0; w < 8; ++w) tot += xss[w * 64 + row];
            const float ri = 1.0f / sqrtf(tot * (1.f / 512.f) + EPS_);
            const f32x4 a = v[it][0] * ri, c = v[it][1] * ri;
            u32x4 o; o.x = pk2(a.x, a.y); o.y = pk2(a.z, a.w); o.z = pk2(c.x, c.y); o.w = pk2(c.z, c.w);
            *(u32x4*)(AB + (R0 + row) * 1024 + 512 + n * 64 + c8 * 8) = o; }
        __syncthreads();
    }
}


constexpr size_t WS_FLG = 32768;
__device__ __forceinline__ void lru_item_1p(const Args& A, int l, int b, int chunk, LAS unsigned char* lds, int wave) {
    const int tid = tid_of(wave); const int lane = tid & 63;
    const int n = wave, r32 = lane & 31, hi = lane >> 5;
    const size_t R0 = (size_t)b * S_ + (size_t)chunk * 64; const int t0 = chunk * 64;
    const bf16_t* XR = (const bf16_t*)(A.ws + WS_XR);
    unsigned long long* AGG2 = (unsigned long long*)(A.ws + WS_AGG2) + (size_t)(l * 512 + b * 128) * 512;
    LAS unsigned char* wreg = lds + wave * LRU_WREG;
    u32x4 tv[9]; float wv[5];
    const bf16_t* Wa = (const bf16_t*)(A.ws + WS_W + (size_t)l * WL_STRIDE + W_A) + n * 4096;
    const bf16_t* Wx = (const bf16_t*)(A.ws + WS_W + (size_t)l * WL_STRIDE + W_X) + n * 4096;
    float nbav[2], nbxv[2], lamv[2];
    { const int c8 = lane & 7;
#pragma unroll
      for (int i = 0; i < 9; ++i) { const int rr = (lane >> 3) + 8 * i; const int tt = t0 + rr - 3; const bool ok = (rr < 67) && (tt >= 0);
          const long dr = ok ? (long)(rr - 3) : 0; const u32x4 v = *(const u32x4*)(XR + (R0 + dr) * 512 + n * 64 + c8 * 8); tv[i] = ok ? v : (u32x4){0u, 0u, 0u, 0u}; }
#pragma unroll
      for (int j = 0; j < 4; ++j) wv[j] = A.in[I_CONV_W][l * 2048 + j * 512 + n * 64 + lane];
      wv[4] = A.in[I_CONV_B][l * 512 + n * 64 + lane];
#pragma unroll
      for (int nt = 0; nt < 2; ++nt) { const int e = 32 * nt + r32, ch = n * 64 + e;
          nbav[nt] = A.in[I_LRU_BA][l * 512 + ch]; nbxv[nt] = A.in[I_LRU_BX][l * 512 + ch]; lamv[nt] = A.in[I_LRU_LAM][l * 512 + ch]; } }
    { const int c8 = lane & 7;
#pragma unroll
      for (int i = 0; i < 9; ++i) { const int rr = (lane >> 3) + 8 * i; if (rr < 67) *(LAS u32x4*)(wreg + rr * 144 + c8 * 16) = tv[i]; }
      LAS float* wl_ = (LAS float*)(wreg + 9728);
#pragma unroll
      for (int j = 0; j < 5; ++j) wl_[j * 64 + lane] = wv[j]; }
    LDS_WAIT(); asm volatile("" ::: "memory");
    bf16x8 xa[2][4];
    { const LAS float* wl_ = (const LAS float*)(wreg + 9728);
#pragma unroll
      for (int ks = 0; ks < 4; ++ks) { const int cl0 = 16 * ks + 8 * hi;
          f32x4 w0[4], w1[4];
#pragma unroll
          for (int j = 0; j < 4; ++j) { w0[j] = *(const LAS f32x4*)(wl_ + j * 64 + cl0); w1[j] = *(const LAS f32x4*)(wl_ + j * 64 + cl0 + 4); }
          const f32x4 b0 = *(const LAS f32x4*)(wl_ + 256 + cl0), b1 = *(const LAS f32x4*)(wl_ + 256 + cl0 + 4);
#pragma unroll
          for (int mt = 0; mt < 2; ++mt) { f32x4 a0 = b0, a1 = b1;
#pragma unroll
              for (int j = 0; j < 4; ++j) { const u32x4 v = *(const LAS u32x4*)(wreg + (32 * mt + r32 + j) * 144 + cl0 * 2);
                  a0 += w0[j] * (f32x4){bflo(v.x), bfhi(v.x), bflo(v.y), bfhi(v.y)}; a1 += w1[j] * (f32x4){bflo(v.z), bfhi(v.z), bflo(v.w), bfhi(v.w)}; }
              u32x4 pw; pw.x = pk2(a0.x, a0.y); pw.y = pk2(a0.z, a0.w); pw.z = pk2(a1.x, a1.y); pw.w = pk2(a1.z, a1.w);
              xa[mt][ks] = __builtin_bit_cast(bf16x8, pw); } } }
    f32x16 Av[2][2], Bv[2][2];
#pragma unroll
    for (int nt = 0; nt < 2; ++nt) {
        const int e = 32 * nt + r32, ch = n * 64 + e;
        f32x16 Rr[2] = {}, Ii[2] = {}, Xc[2] = {};
#pragma unroll
        for (int ks = 0; ks < 4; ++ks) {
            const bf16x8 wa = *(const bf16x8*)(Wa + e * 64 + 16 * ks + 8 * hi), wx = *(const bf16x8*)(Wx + e * 64 + 16 * ks + 8 * hi);
            bf16x8 idf;
#pragma unroll
            for (int j = 0; j < 8; ++j) idf[j] = (16 * ks + 8 * hi + j == e) ? (short)0x3F80 : (short)0;
#pragma unroll
            for (int mt = 0; mt < 2; ++mt) {
                Rr[mt] = __builtin_amdgcn_mfma_f32_32x32x16_bf16(xa[mt][ks], wa, Rr[mt], 0, 0, 0);
                Ii[mt] = __builtin_amdgcn_mfma_f32_32x32x16_bf16(xa[mt][ks], wx, Ii[mt], 0, 0, 0);
                Xc[mt] = __builtin_amdgcn_mfma_f32_32x32x16_bf16(xa[mt][ks], idf, Xc[mt], 0, 0, 0); } }
        const float nba = -LOG2E_ * nbav[nt], nbx = -LOG2E_ * nbxv[nt], lam = lamv[nt];
        const float xl_ = ex2(-LOG2E_ * lam);
        const float cl2 = -8.0f * LOG2E_ * (xl_ < 0.03f ? xl_ * (1.0f - xl_ * (0.5f - xl_ * (0.33333334f - xl_ * 0.25f))) : __builtin_amdgcn_logf(1.0f + xl_) * 0.69314718f);
#pragma unroll
        for (int mt = 0; mt < 2; ++mt)
#pragma unroll
            for (int r = 0; r < 16; ++r) { const float rg = rcp(1.0f + ex2(__builtin_fmaf(Rr[mt][r], -LOG2E_, nba))), ig = rcp(1.0f + ex2(__builtin_fmaf(Ii[mt][r], -LOG2E_, nbx))); const float av = ex2(cl2 * rg);
                Av[nt][mt][r] = av; Bv[nt][mt][r] = __builtin_amdgcn_sqrtf(__builtin_fmaf(-av, av, 1.0f)) * (ig * Xc[mt][r]); }
        float H = 0.f, Atot = 1.f;
#pragma unroll
        for (int gi = 0; gi < 8; ++gi) { const int mt = gi >> 2, i = gi & 3; float a = 1.f, bq = 0.f;
#pragma unroll
            for (int j = 0; j < 4; ++j) { const float aa = Av[nt][mt][4 * i + j]; bq = aa * bq + Bv[nt][mt][4 * i + j]; a *= aa; }
            const auto ra = __builtin_amdgcn_permlane32_swap(__float_as_uint(a), __float_as_uint(a), false, false); const auto rb = __builtin_amdgcn_permlane32_swap(__float_as_uint(bq), __float_as_uint(bq), false, false);
            const float A0 = __uint_as_float(ra[0]), A1 = __uint_as_float(ra[1]), B0 = __uint_as_float(rb[0]), B1 = __uint_as_float(rb[1]);
            H = A0 * H + B0; H = A1 * H + B1; Atot *= A0 * A1; }
        if (hi == 0) __hip_atomic_store(AGG2 + (size_t)chunk * 512 + ch, ((unsigned long long)__float_as_uint(H) << 32) | (unsigned long long)__float_as_uint(fmaxf(Atot, 1e-37f)),
                                        __ATOMIC_RELAXED, __HIP_MEMORY_SCOPE_AGENT);
    }
    { const int tidF = tid_of(wave); const unsigned long long* ag = AGG2 + tidF; float H = 0.f;
      for (int c = 0; c < chunk; c += 16) { unsigned long long v[16]; unsigned sp = 0;
          for (;;) { bool ok = true;
#pragma unroll
              for (int q = 0; q < 16; ++q) { const int cc = (c + q < chunk) ? c + q : chunk - 1; v[q] = __hip_atomic_load(ag + (size_t)cc * 512, __ATOMIC_RELAXED, __HIP_MEMORY_SCOPE_AGENT); ok = ok && ((unsigned)v[q] != 0u); }
              if (ok) break;
              __builtin_amdgcn_s_sleep(2); if (++sp > (1u << 22)) break; }
#pragma unroll
          for (int q = 0; q < 16; ++q) H = (c + q < chunk) ? __uint_as_float((unsigned)v[q]) * H + __uint_as_float((unsigned)(v[q] >> 32)) : H; }
      ((LAS float*)(lds + LRU_CARRY))[tidF] = H; }
    const bf16_t* YG = (const bf16_t*)(A.ws + WS_YG);
    u32x4 yv[8];
#pragma unroll
    for (int it = 0; it < 8; ++it) { const int laneY = tid_of(wave) & 63; yv[it] = *(const u32x4*)(YG + (R0 + it * 8 + (laneY >> 3)) * 512 + n * 64 + (laneY & 7) * 8); }
    __syncthreads();
    LAS float* stage = (LAS float*)wreg;
    const int tid3 = tid_of(wave); const int hi3 = (tid3 >> 5) & 1;
#pragma unroll
    for (int nt = 0; nt < 2; ++nt) {
        const int e = 32 * nt + r32, ch = n * 64 + e;
        float H = ((const LAS float*)(lds + LRU_CARRY))[ch];
#pragma unroll
        for (int gi = 0; gi < 8; ++gi) { const int mt = gi >> 2, i = gi & 3; float a = 1.f, bq = 0.f;
#pragma unroll
            for (int j = 0; j < 4; ++j) { const float aa = Av[nt][mt][4 * i + j]; bq = aa * bq + Bv[nt][mt][4 * i + j]; a *= aa; }
            const auto ra = __builtin_amdgcn_permlane32_swap(__float_as_uint(a), __float_as_uint(a), false, false); const auto rb = __builtin_amdgcn_permlane32_swap(__float_as_uint(bq), __float_as_uint(bq), false, false);
            const float A0 = __uint_as_float(ra[0]), A1 = __uint_as_float(ra[1]), B0 = __uint_as_float(rb[0]), B1 = __uint_as_float(rb[1]);
            const float h0 = H; H = A0 * H + B0; const float h1 = H; H = A1 * H + B1;
            float h = hi3 ? h1 : h0;
#pragma unroll
            for (int j = 0; j < 4; ++j) { h = Av[nt][mt][4 * i + j] * h + Bv[nt][mt][4 * i + j]; stage[(32 * mt + 8 * i + 4 * hi3 + j) * 68 + e] = h; } }
    }
    LDS_WAIT(); asm volatile("" ::: "memory");
    { bf16_t* AB = (bf16_t*)(A.ws + WS_AB); const int laneO = tid_of(wave) & 63;
      LAS float* xss = (LAS float*)(lds + LRU_XSS);
      f32x4 v[8][2];
#pragma unroll
      for (int it = 0; it < 8; ++it) { const int row = it * 8 + (laneO >> 3), c8 = laneO & 7;
          const f32x4 h0 = *(const LAS f32x4*)(stage + row * 68 + c8 * 8), h1 = *(const LAS f32x4*)(stage + row * 68 + c8 * 8 + 4);
          const u32x4 y = yv[it];
          v[it][0] = h0 * (f32x4){bflo(y.x), bfhi(y.x), bflo(y.y), bfhi(y.y)}; v[it][1] = h1 * (f32x4){bflo(y.z), bfhi(y.z), bflo(y.w), bfhi(y.w)};
          float ss = (v[it][0].x * v[it][0].x + v[it][0].y * v[it][0].y) + (v[it][0].z * v[it][0].z + v[it][0].w * v[it][0].w)
                   + (v[it][1].x * v[it][1].x + v[it][1].y * v[it][1].y) + (v[it][1].z * v[it][1].z + v[it][1].w * v[it][1].w);
          ss += __uint_as_float(__builtin_amdgcn_update_dpp(0u, __float_as_uint(ss), 0xB1, 0xF, 0xF, false)); ss += __uint_as_float(__builtin_amdgcn_update_dpp(0u, __float_as_uint(ss), 0x4E, 0xF, 0xF, false)); ss += __uint_as_float(__builtin_amdgcn_update_dpp(0u, __float_as_uint(ss), 0x141, 0xF, 0xF, false));
          if (c8 == 0) xss[row * 8 + wave] = ss; }
      __syncthreads();
#pragma unroll
      for (int it = 0; it < 8; ++it) { const int row = it * 8 + (laneO >> 3), c8 = laneO & 7;
          const f32x4 p0 = *(const LAS f32x4*)(xss + row * 8), p1 = *(const LAS f32x4*)(xss + row * 8 + 4);
          const float tot = ((((((p0.x + p0.y) + p0.z) + p0.w) + p1.x) + p1.y) + p1.z) + p1.w;
          const float ri = __builtin_amdgcn_rsqf(tot * (1.f / 512.f) + EPS_);
          const f32x4 a = v[it][0] * ri, c = v[it][1] * ri;
          u32x4 o; o.x = pk2(a.x, a.y); o.y = pk2(a.z, a.w); o.z = pk2(c.x, c.y); o.w = pk2(c.z, c.w);
          *(u32x4*)(AB + (R0 + row) * 1024 + 512 + n * 64 + c8 * 8) = o; }
      __syncthreads(); }
}

constexpr int NS_KV = 0, NS_KC = 0, NS_VC = 18432, NS_IMP = 35840;
constexpr int NS_OSP = 0, NS_LSP = 66560, NS_MREF = 67584, NS_QT = 69632, NS_SLOT = 102400;
constexpr int NS_SEL = 103936, NS_LUT = 104960, NS_SS = 111104, NS_ATT = 111616, NS_QCTR = 145408;
constexpr int LUTN = 192;
constexpr int OSPP = 65;
constexpr int KPITCH = 144;
constexpr int VCPITCH = 272;
constexpr int IMPP = 132;
constexpr int ATTP = 264;


struct SoftSt { float m, l; f32x16 o[2]; };
#define MX3(a, b, c) __builtin_fmaxf(__builtin_fmaxf((a), (b)), (c))
__device__ __forceinline__ void attn_step(const LAS unsigned char* Kt, const LAS unsigned char* Vt, const bf16x8 (&qr)[4], float cinit, bool masked, bool first,
                                          int tq, int kpos0, int lo_excl, const LAS float* lut_h, SoftSt& st, int r32, int hi) {
    bf16x8 kf[2][4];
#pragma unroll
    for (int kt = 0; kt < 2; ++kt)
#pragma unroll
        for (int ds = 0; ds < 4; ++ds) kf[kt][ds] = *(const LAS bf16x8*)(Kt + (32 * kt + r32) * KPITCH + (16 * ds + 8 * hi) * 2);
    __builtin_amdgcn_sched_barrier(0);
    f32x16 sc[2], cvec;
    const float c0 = cinit - st.m;
#pragma unroll
    for (int r = 0; r < 16; ++r) cvec[r] = c0;
#pragma unroll
    for (int ds = 0; ds < 4; ++ds)
#pragma unroll
        for (int kt = 0; kt < 2; ++kt) sc[kt] = __builtin_amdgcn_mfma_f32_32x32x16_bf16(kf[kt][ds], qr[ds], ds == 0 ? cvec : sc[kt], 0, 0, 0);
    bf16x8 vf[2][2][2];
#pragma unroll
    for (int kt = 0; kt < 2; ++kt)
#pragma unroll
        for (int s = 0; s < 2; ++s)
#pragma unroll
            for (int dt = 0; dt < 2; ++dt) vf[kt][s][dt] = *(const LAS bf16x8*)(Vt + (32 * dt + r32) * KPITCH + (32 * kt + 16 * s + 8 * hi) * 2);
    __builtin_amdgcn_sched_barrier(0);
    if (masked) {
#pragma unroll
        for (int kt = 0; kt < 2; ++kt) { float bv[16];
            asm volatile("" ::: "memory");
#pragma unroll
            for (int r = 0; r < 16; ++r) { const int dist = tq - (kpos0 + 32 * kt + crow(r, hi)); const int di = dist < 0 ? 0 : (dist > LUTN - 1 ? LUTN - 1 : dist); bv[r] = lut_h[di]; }
#pragma unroll
            for (int r = 0; r < 16; ++r) { const int pos = kpos0 + 32 * kt + crow(r, hi); const bool ok = (tq >= pos) && (pos > lo_excl); sc[kt][r] = ok ? sc[kt][r] + bv[r] : NEG_; } }
    }
    float mx = MX3(sc[0][0], sc[1][0], sc[0][1]);
#pragma unroll
    for (int r = 2; r < 16; r += 2) mx = MX3(mx, sc[0][r], sc[1][r - 1]), mx = MX3(mx, sc[0][r + 1], sc[1][r]);
    mx = fmaxf(mx, sc[1][15]);
    mx = fmaxf(mx, shx(mx, 32));
    if (first || __any(mx > 8.0f)) { const float dl = first ? mx : fmaxf(mx, 0.f); const float corr = ex2(-dl); st.m += dl; st.l *= corr;
#pragma unroll
        for (int kt = 0; kt < 2; ++kt)
#pragma unroll
            for (int r = 0; r < 16; ++r) { sc[kt][r] -= dl; st.o[kt][r] *= corr; } }
    f32x2 ls2 = {0.f, 0.f};
#pragma unroll
    for (int kt = 0; kt < 2; ++kt)
#pragma unroll
        for (int s = 0; s < 2; ++s) {
#pragma unroll
            for (int j = 0; j < 8; j += 2) { const float e0 = ex2(sc[kt][8 * s + j]), e1 = ex2(sc[kt][8 * s + j + 1]); sc[kt][8 * s + j] = e0; sc[kt][8 * s + j + 1] = e1; ls2 += (f32x2){e0, e1}; }
            u32x4 pw; pw.x = cvt_pk_bf16(sc[kt][8 * s + 0], sc[kt][8 * s + 1]); pw.y = cvt_pk_bf16(sc[kt][8 * s + 2], sc[kt][8 * s + 3]);
            pw.z = cvt_pk_bf16(sc[kt][8 * s + 4], sc[kt][8 * s + 5]); pw.w = cvt_pk_bf16(sc[kt][8 * s + 6], sc[kt][8 * s + 7]);
            const bf16x8 pf = __builtin_bit_cast(bf16x8, pw);
#pragma unroll
            for (int dt = 0; dt < 2; ++dt) st.o[dt] = __builtin_amdgcn_mfma_f32_32x32x16_bf16(vf[kt][s][dt], pf, st.o[dt], 0, 0, 0); }
    st.l += ls2.x + ls2.y;
}

#define NSA_IDS() const int tid = tid_of(wave); const int lane = tid & 63, r32 = lane & 31, hi = lane >> 5; const int tl = 8 * wave + (r32 >> 2), hh = r32 & 3; \
    const int tq = 64 * tile + tl; const size_t R = rowbase + tq; const int hg = g * 4 + hh; const LAS float* lut_h = (const LAS float*)(lds + NS_LUT) + hg * LUTN; (void)lane; (void)R; (void)lut_h; (void)tq; (void)hi
#define NSA_LOADQ() bf16x8 qr[4]; _Pragma("unroll") for (int ds = 0; ds < 4; ++ds) qr[ds] = *(const LAS bf16x8*)(lds + NS_QT + (32 * wave + r32) * 128 + (((2 * ds + hi) ^ (r32 & 7)) << 4))

template <int variant>
__device__ __forceinline__ void nsa_item(const Args& A, int l, int b, int tile, LAS unsigned char* lds, int wave) {
    const int cur = tile; const size_t rowbase = (size_t)b * S_;
    const int nkb = cur >= 64 ? 2 : 1;
#pragma unroll 1
    for (int g = 0; g < 2; ++g) {
        float gate3[3];
        { NSA_IDS(); const float* gp = (const float*)(A.ws + WS_GATES) + R * 24 + hg * 3; gate3[0] = gp[0]; gate3[1] = gp[1]; gate3[2] = gp[2]; }
        {
            NSA_IDS();
            LAS float* imp = (LAS float*)(lds + NS_IMP);
            { const bf16_t* kcb = (const bf16_t*)(A.ws + WS_KCB) + (size_t)(g * 4 + b) * 128 * 64; const bf16_t* vct = (const bf16_t*)(A.ws + WS_VCT) + (size_t)(g * 4 + b) * 8192;
              u32x4 kv[2], vv[2], qv[4];
#pragma unroll
              for (int i = 0; i < 2; ++i) { const int idx = tid + NTHREADS * i; kv[i] = *(const u32x4*)(kcb + idx * 8); vv[i] = *(const u32x4*)(vct + idx * 8); }
#pragma unroll
              for (int i = 0; i < 4; ++i) { const int idx = tid + NTHREADS * i; const int row = idx >> 3, c = idx & 7;
                  qv[i] = *(const u32x4*)((const bf16_t*)(A.ws + WS_QB) + (rowbase + 64 * tile + (row >> 2)) * 512 + (g * 4 + (row & 3)) * 64 + c * 8); }
#pragma unroll
              for (int i = 0; i < 4; ++i) { const int idx = tid + NTHREADS * i; const int row = idx >> 3, c = idx & 7; *(LAS u32x4*)(lds + NS_QT + row * 128 + ((c ^ (row & 7)) << 4)) = qv[i]; }
#pragma unroll
              for (int i = 0; i < 2; ++i) { const int idx = tid + NTHREADS * i;
                  *(LAS u32x4*)(lds + NS_KC + (idx >> 3) * KPITCH + (idx & 7) * 16) = kv[i];
                  *(LAS u32x4*)(lds + NS_VC + (idx >> 4) * VCPITCH + (idx & 15) * 16) = vv[i]; } }
            __syncthreads();
            NSA_LOADQ();
            const float b31c = lut_h[LUTN - 1];
            f32x16 pc[4];
            float mx = NEG_;
#pragma unroll
            for (int kq = 0; kq < 4; ++kq) {
#pragma unroll
                for (int r = 0; r < 16; ++r) pc[kq][r] = NEG_;
                if (kq < 2 * nkb) {
                    f32x16 p = {};
#pragma unroll
                    for (int ds = 0; ds < 4; ++ds) { const bf16x8 kf = *(const LAS bf16x8*)(lds + NS_KC + (32 * kq + r32) * KPITCH + (16 * ds + 8 * hi) * 2);
                        p = __builtin_amdgcn_mfma_f32_32x32x16_bf16(kf, qr[ds], p, 0, 0, 0); }
                    if (32 * kq + 31 >= cur - 2) {
#pragma unroll
                        for (int r = 0; r < 16; ++r) { const int j = 32 * kq + crow(r, hi); const int dist = tq - (64 * j + 63); const bool ok = dist >= 0;
                            const int di = dist < 0 ? 0 : (dist > LUTN - 1 ? LUTN - 1 : dist);
                            const float sv = ok ? p[r] + lut_h[di] : NEG_; pc[kq][r] = sv; mx = fmaxf(mx, sv); }
                    } else {
#pragma unroll
                        for (int r = 0; r < 16; ++r) { const float sv = p[r] + b31c; pc[kq][r] = sv; mx = fmaxf(mx, sv); } }
                } }
            { const auto rr = __builtin_amdgcn_permlane32_swap(__float_as_uint(mx), __float_as_uint(mx), false, false); mx = fmaxf(__uint_as_float(rr[0]), __uint_as_float(rr[1])); }
            float lsum = 0.f;
#pragma unroll
            for (int kq = 0; kq < 4; ++kq)
#pragma unroll
                for (int r = 0; r < 16; ++r) { const float e = (pc[kq][r] > -1e29f) ? ex2(pc[kq][r] - mx) : 0.f; pc[kq][r] = e; lsum += e; }
            { const auto rr = __builtin_amdgcn_permlane32_swap(__float_as_uint(lsum), __float_as_uint(lsum), false, false); lsum = __uint_as_float(rr[0]) + __uint_as_float(rr[1]); }
            const float inv = rcp(fmaxf(lsum, 1e-30f));
            f32x16 oc[2] = {};
#pragma unroll
            for (int kq = 0; kq < 4; ++kq) {
                if (kq < 2 * nkb) {
#pragma unroll
                    for (int r = 0; r < 16; ++r) pc[kq][r] *= inv;
#pragma unroll
                    for (int s2 = 0; s2 < 2; ++s2) {
                        u32x4 pw; pw.x = cvt_pk_bf16(pc[kq][8 * s2 + 0], pc[kq][8 * s2 + 1]); pw.y = cvt_pk_bf16(pc[kq][8 * s2 + 2], pc[kq][8 * s2 + 3]);
                        pw.z = cvt_pk_bf16(pc[kq][8 * s2 + 4], pc[kq][8 * s2 + 5]); pw.w = cvt_pk_bf16(pc[kq][8 * s2 + 6], pc[kq][8 * s2 + 7]);
                        const bf16x8 pf = __builtin_bit_cast(bf16x8, pw);
#pragma unroll
                        for (int dt = 0; dt < 2; ++dt) { const LAS unsigned char* vp = lds + NS_VC + (32 * dt + r32) * VCPITCH + (32 * kq + 16 * s2 + 4 * hi) * 2;
                            const u32x2 lo = *(const LAS u32x2*)vp, hi8 = *(const LAS u32x2*)(vp + 16);
                            const u32x4 vw = {lo.x, lo.y, hi8.x, hi8.y};
                            oc[dt] = __builtin_amdgcn_mfma_f32_32x32x16_bf16(__builtin_bit_cast(bf16x8, vw), pf, oc[dt], 0, 0, 0); } }
#pragma unroll
                    for (int r = 0; r < 16; ++r) { float v = pc[kq][r];
                        v += __uint_as_float(__builtin_amdgcn_update_dpp(0u, __float_as_uint(v), 0xB1, 0xF, 0xF, false)); v += __uint_as_float(__builtin_amdgcn_update_dpp(0u, __float_as_uint(v), 0x4E, 0xF, 0xF, false));
                        if (hh == 0) imp[tl * IMPP + 32 * kq + crow(r, hi)] = v; }
                } }
            const float gc = gate3[0];
            { LAS bf16_t* att = (LAS bf16_t*)(lds + NS_ATT);
#pragma unroll
              for (int dt = 0; dt < 2; ++dt)
#pragma unroll
                for (int q4 = 0; q4 < 4; ++q4) { u32x2 w; w.x = pk2(gc * oc[dt][4 * q4 + 0], gc * oc[dt][4 * q4 + 1]); w.y = pk2(gc * oc[dt][4 * q4 + 2], gc * oc[dt][4 * q4 + 3]);
                    *(LAS u32x2*)(att + tl * ATTP + hh * 64 + 32 * dt + 8 * q4 + 4 * hi) = w; } }
            __syncthreads();
        }
        u32x4 pk, pv;
        { const int tidp = tid_of(wave); const int trow = tidp >> 3, tch = (tidp & 7) * 8;
          pk = *(const u32x4*)((const bf16_t*)(A.ws + WS_KP) + (size_t)(1 * 2 + g) * T_ * 64 + (rowbase + trow) * 64 + tch);
          pv = *(const u32x4*)((const bf16_t*)(A.ws + WS_VT) + (size_t)(1 * 128 + g * 64) * T_ + (size_t)trow * T_ + rowbase + tch); }
        {
            const int tid = tid_of(wave);
            const LAS float* imp = (const LAS float*)(lds + NS_IMP); LAS unsigned short* sel16 = (LAS unsigned short*)(lds + NS_SEL);
            const int tk = tid >> 3, sub = tid & 7, jb = sub * 16;
            const int need = 16 - (cur + 1 < 3 ? cur + 1 : 3);
            unsigned key[16];
#pragma unroll
            for (int c = 0; c < 16; ++c) { const int j = jb + c; const bool cand = (j >= 1) && (j <= cur - 2); const float v = (j < nkb * 64) ? imp[tk * IMPP + j] : 0.f; key[c] = cand ? __float_as_uint(v) + 1u : 0u; }
            unsigned T = 0u;
#pragma unroll 1
            for (int bit = 30; bit >= 0; --bit) { const unsigned t = T | (1u << bit); int cnt = 0;
#pragma unroll
                for (int c = 0; c < 16; ++c) cnt += (key[c] >= t) ? 1 : 0;
                cnt += __builtin_amdgcn_update_dpp(0, cnt, 0xB1, 0xF, 0xF, false); cnt += __builtin_amdgcn_update_dpp(0, cnt, 0x4E, 0xF, 0xF, false); cnt += __builtin_amdgcn_update_dpp(0, cnt, 0x141, 0xF, 0xF, false);
                if (cnt >= need) T = t;
                if (cnt == need) break; }
            int ngt = 0, neq = 0;
#pragma unroll
            for (int c = 0; c < 16; ++c) { ngt += (key[c] > T) ? 1 : 0; neq += (key[c] == T && T != 0u) ? 1 : 0; }
            int ngt_all = ngt; ngt_all += __builtin_amdgcn_update_dpp(0, ngt_all, 0xB1, 0xF, 0xF, false); ngt_all += __builtin_amdgcn_update_dpp(0, ngt_all, 0x4E, 0xF, 0xF, false); ngt_all += __builtin_amdgcn_update_dpp(0, ngt_all, 0x141, 0xF, 0xF, false);
            int pre = neq;
            { int t1 = shup8(pre, 1); if (sub >= 1) pre += t1; int t2 = shup8(pre, 2); if (sub >= 2) pre += t2; int t4 = shup8(pre, 4); if (sub >= 4) pre += t4; pre -= neq; }
            const int rem = need - ngt_all;
            unsigned mask = 0; int run = pre;
#pragma unroll
            for (int c = 0; c < 16; ++c) { const int j = jb + c; const bool forced = (j == 0) || (j == cur) || (j == cur - 1); bool sel = key[c] > T;
                if (key[c] == T && T != 0u) { sel = run < rem; ++run; }
                if (sel || forced) mask |= (1u << c); }
            sel16[tk * 8 + sub] = (unsigned short)mask;
            __syncthreads();
        }
#pragma unroll 1
        for (int br = 0; br < 2; ++br) {
            NSA_IDS();
            NSA_LOADQ();
            const float b31 = lut_h[LUTN - 1];
            const LAS unsigned* selw = (const LAS unsigned*)(lds + NS_SEL) + tl * 4;
            const bf16_t* Kp = (const bf16_t*)(A.ws + WS_KP) + (size_t)((br == 0 ? 1 : 2) * 2 + g) * T_ * 64;
            const bf16_t* Vp = (const bf16_t*)(A.ws + WS_VT) + (size_t)((br == 0 ? 1 : 2) * 128 + g * 64) * T_;
            const int nblk = br == 0 ? (cur + 1 < 4 ? cur + 1 : 4) : (cur < 8 ? cur + 1 : 9);
#define KBI(i_) (br == 0 ? ((i_) == 0 ? 0 : cur - (nblk - 1 - (i_))) : cur - (i_))
            SoftSt st; st.m = 0.f; st.l = 0.f; st.o[0] = (f32x16){}; st.o[1] = (f32x16){};
            const int trow = tid >> 3, tch = (tid & 7) * 8;
            const bf16_t* kg = Kp + (rowbase + trow) * 64 + tch;
            const bf16_t* vg = Vp + (size_t)trow * T_ + rowbase + tch;
            LAS unsigned char* kl = lds + NS_KV + trow * KPITCH + tch * 2;
            LAS unsigned char* vl = lds + NS_KV + trow * KPITCH + ((tch >> 4) * 16 + ((tch >> 3) & 1) * 4) * 2;
#define NSA_LD(kr, vr, i_) asm volatile("global_load_dwordx4 %0, %2, off\n\tglobal_load_dwordx4 %1, %3, off" : "=&v"(kr), "=&v"(vr) : "v"(kg + (long)KBC(i_) * 4096), "v"(vg + (long)KBC(i_) * 64) : "memory")
#define NSA_WAIT(kr, vr, n) asm volatile("s_waitcnt vmcnt(" #n ")" : "+v"(kr), "+v"(vr) : : "memory")
#define NSA_ST(kr, vr, i_) do { *(LAS u32x4*)(kl + ((i_) & 1) * 18432) = kr; \
                *(LAS u32x2*)(vl + ((i_) & 1) * 18432 + 9216) = (u32x2){vr.x, vr.y}; *(LAS u32x2*)(vl + ((i_) & 1) * 18432 + 9216 + 16) = (u32x2){vr.z, vr.w}; } while (0)
#define NSA_STEP(i_) do { const int kb = KBI(i_); const bool masked = (cur - kb <= 2) || (br == 1 && cur - kb == 8); bool selected = true; \
                if (br == 0) selected = (selw[kb >> 5] >> (kb & 31)) & 1u; \
                if (__ballot(selected) != 0ull) { const float cinit = selected ? (masked ? 0.f : b31) : NEG_; \
                    attn_step(lds + NS_KV + ((i_) & 1) * 18432, lds + NS_KV + ((i_) & 1) * 18432 + 9216, qr, cinit, masked, (i_) == 0, tq, 64 * kb, br == 1 ? tq - 512 : -1, lut_h, st, r32, hi); } } while (0)
#define KBC(i_) KBI((i_) < nblk ? (i_) : nblk - 1)
            u32x4 kA, vA, kB, vB;
            asm volatile("" : "+v"(qr[0]), "+v"(qr[1]), "+v"(qr[2]), "+v"(qr[3]));
            kA = pk; vA = pv; NSA_ST(kA, vA, 0);
            NSA_LD(kA, vA, 1); NSA_LD(kB, vB, 2);
            __syncthreads();
#pragma unroll 1
            for (int i = 0; i < nblk; i += 2) {
                NSA_STEP(i);
                NSA_WAIT(kA, vA, 2); NSA_ST(kA, vA, 1); NSA_LD(kA, vA, i + 3);
                __syncthreads();
                if (i + 1 >= nblk) break;
                NSA_STEP(i + 1);
                NSA_WAIT(kB, vB, 2); NSA_ST(kB, vB, 0); NSA_LD(kB, vB, i + 4);
                __syncthreads();
            }
            asm volatile("s_waitcnt vmcnt(0)" : "+v"(kA), "+v"(vA), "+v"(kB), "+v"(vB) : : "memory");
            if (br == 0) {
                pk = *(const u32x4*)((const bf16_t*)(A.ws + WS_KP) + (size_t)(2 * 2 + g) * T_ * 64 + (rowbase + trow) * 64 + tch + (long)cur * 4096);
                pv = *(const u32x4*)((const bf16_t*)(A.ws + WS_VT) + (size_t)(2 * 128 + g * 64) * T_ + (size_t)trow * T_ + rowbase + tch + (long)cur * 64); }
#undef KBC
#undef NSA_LD
#undef NSA_WAIT
#undef NSA_ST
#undef NSA_STEP
#undef KBI
            if (br == 0 && cur >= 4) {
                LAS float* osp = (LAS float*)(lds + NS_OSP); LAS float* lsp = (LAS float*)(lds + NS_LSP); LAS float* mrf = (LAS float*)(lds + NS_MREF);
                { f32x4 z = {0.f, 0.f, 0.f, 0.f};
                  for (int i = tid; i < 4224; i += NTHREADS) *(LAS f32x4*)(lds + NS_OSP + i * 16) = z; }
                LAS float* scl = (LAS float*)(lds + NS_SLOT + 512);
                { const float ld = st.l + shx(st.l, 32); const int e_ = (int)((__float_as_uint(fmaxf(ld, 1e-30f)) >> 23) & 255u) - 126;
                  if (hi == 0) { mrf[32 * wave + r32] = st.m - (float)(20 - e_); scl[32 * wave + r32] = __uint_as_float((unsigned)(127 + 20 - e_) << 23); } }
                if (tid == 0) *(LAS int*)(lds + NS_QCTR) = 1;
                __syncthreads();
                const bf16_t* Kf1 = (const bf16_t*)(A.ws + WS_KF) + ((size_t)g * (T_ / 64) + (rowbase >> 6)) * 4096 + lane * 8;
                const bf16_t* Vf1 = (const bf16_t*)(A.ws + WS_VF) + ((size_t)g * (T_ / 64) + (rowbase >> 6)) * 4096 + lane * 8;
                LAS unsigned char* slot = lds + NS_SLOT + wave * 64;
                const LAS unsigned* selm = (const LAS unsigned*)(lds + NS_SEL);
                LAS int* qctr = (LAS int*)(lds + NS_QCTR);
#pragma unroll 1
                for (;;) {
                    int kbv = 0; if (lane == 0) kbv = __hip_atomic_fetch_add(qctr, 1, __ATOMIC_RELAXED, __HIP_MEMORY_SCOPE_WORKGROUP);
                    const int kb = __builtin_amdgcn_readfirstlane(kbv);
                    if (kb > cur - 3) break;
                    const bool bit = (selm[lane * 4 + (kb >> 5)] >> (kb & 31)) & 1u;
                    const unsigned long long msk = __ballot(bit); const int cnt = __popcll(msk);
                    if (cnt == 0) continue;
                    if (bit) slot[__builtin_amdgcn_mbcnt_hi((unsigned)(msk >> 32), __builtin_amdgcn_mbcnt_lo((unsigned)msk, 0u))] = (unsigned char)lane;
                    bf16x8 kf[2][4], vf[2][2][2];
#pragma unroll
                    for (int kt = 0; kt < 2; ++kt)
#pragma unroll
                        for (int ds = 0; ds < 4; ++ds) kf[kt][ds] = *(const bf16x8*)(Kf1 + (size_t)kb * 4096 + (kt * 4 + ds) * 512);
#pragma unroll
                    for (int kt = 0; kt < 2; ++kt)
#pragma unroll
                        for (int s2 = 0; s2 < 2; ++s2)
#pragma unroll
                            for (int dt = 0; dt < 2; ++dt) vf[kt][s2][dt] = *(const bf16x8*)(Vf1 + (size_t)kb * 4096 + ((kt * 2 + s2) * 2 + dt) * 512);
                    LDS_WAIT(); asm volatile("" ::: "memory");
#pragma unroll 1
                    for (int c8 = 0; c8 * 8 < cnt; ++c8) {
                        const int si = c8 * 8 + (r32 >> 2); const bool valid = si < cnt; const int tok = slot[valid ? si : 0]; const int row = tok * 4 + hh;
                        bf16x8 qf[4];
#pragma unroll
                        for (int ds = 0; ds < 4; ++ds) qf[ds] = *(const LAS bf16x8*)(lds + NS_QT + row * 128 + (((2 * ds + hi) ^ (row & 7)) << 4));
                        const float c0 = valid ? b31 - mrf[row] : NEG_;
                        f32x16 sc[2], cvec;
#pragma unroll
                        for (int r = 0; r < 16; ++r) cvec[r] = c0;
#pragma unroll
                        for (int ds = 0; ds < 4; ++ds)
#pragma unroll
                            for (int kt = 0; kt < 2; ++kt) sc[kt] = __builtin_amdgcn_mfma_f32_32x32x16_bf16(kf[kt][ds], qf[ds], ds == 0 ? cvec : sc[kt], 0, 0, 0);
                        f32x2 ls2 = {0.f, 0.f}; f32x16 ot[2] = {};
#pragma unroll
                        for (int kt = 0; kt < 2; ++kt)
#pragma unroll
                            for (int s2 = 0; s2 < 2; ++s2) {
#pragma unroll
                                for (int j = 0; j < 8; j += 2) { const float e0 = ex2(fminf(sc[kt][8 * s2 + j], 44.0f)), e1 = ex2(fminf(sc[kt][8 * s2 + j + 1], 44.0f)); sc[kt][8 * s2 + j] = e0; sc[kt][8 * s2 + j + 1] = e1; ls2 += (f32x2){e0, e1}; }
                                u32x4 pw; pw.x = cvt_pk_bf16(sc[kt][8 * s2 + 0], sc[kt][8 * s2 + 1]); pw.y = cvt_pk_bf16(sc[kt][8 * s2 + 2], sc[kt][8 * s2 + 3]);
                                pw.z = cvt_pk_bf16(sc[kt][8 * s2 + 4], sc[kt][8 * s2 + 5]); pw.w = cvt_pk_bf16(sc[kt][8 * s2 + 6], sc[kt][8 * s2 + 7]);
                                const bf16x8 pf = __builtin_bit_cast(bf16x8, pw);
#pragma unroll
                                for (int dt = 0; dt < 2; ++dt) ot[dt] = __builtin_amdgcn_mfma_f32_32x32x16_bf16(vf[kt][s2][dt], pf, ot[dt], 0, 0, 0); }
                        float ls = ls2.x + ls2.y;
                        { const auto rr = __builtin_amdgcn_permlane32_swap(__float_as_uint(ls), __float_as_uint(ls), false, false); ls = __uint_as_float(rr[0]) + __uint_as_float(rr[1]); }
                        if (valid) {
#pragma unroll
                            for (int dt = 0; dt < 2; ++dt)
#pragma unroll
                                for (int r = 0; r < 16; ++r) __hip_atomic_fetch_add((LAS int*)osp + row * OSPP + 32 * dt + crow(r, hi), (int)__builtin_amdgcn_fmed3f(ot[dt][r], -6.0e7f, 6.0e7f), __ATOMIC_RELAXED, __HIP_MEMORY_SCOPE_WORKGROUP);
                            if (hi == 0) __hip_atomic_fetch_add((LAS int*)lsp + row, (int)fminf(ls, 6.0e7f), __ATOMIC_RELAXED, __HIP_MEMORY_SCOPE_WORKGROUP); }
                    }
                }
                __syncthreads();
                { const int row = 32 * wave + r32; const float isr = rcp(scl[row]);
#pragma unroll
                  for (int dt = 0; dt < 2; ++dt)
#pragma unroll
                    for (int r = 0; r < 16; ++r) st.o[dt][r] += (float)((const LAS int*)osp)[row * OSPP + 32 * dt + crow(r, hi)] * isr;
                  if (hi == 0) st.l += (float)((const LAS int*)lsp)[row] * isr; }
                __syncthreads();
            }
            const float lt = st.l + shx(st.l, 32);
            const float gg = (br == 0 ? gate3[1] : gate3[2]) * rcp(lt);
            LAS bf16_t* att = (LAS bf16_t*)(lds + NS_ATT);
            float ss = 0.f;
#pragma unroll
            for (int dt = 0; dt < 2; ++dt)
#pragma unroll
                for (int q4 = 0; q4 < 4; ++q4) { LAS u32x2* ap = (LAS u32x2*)(att + tl * ATTP + hh * 64 + 32 * dt + 8 * q4 + 4 * hi); const u32x2 pv = *ap;
                    const float a0 = bflo(pv.x) + gg * st.o[dt][4 * q4 + 0], a1 = bfhi(pv.x) + gg * st.o[dt][4 * q4 + 1], a2 = bflo(pv.y) + gg * st.o[dt][4 * q4 + 2], a3 = bfhi(pv.y) + gg * st.o[dt][4 * q4 + 3];
                    ss += (a0 * a0 + a1 * a1) + (a2 * a2 + a3 * a3);
                    u32x2 w; w.x = pk2(a0, a1); w.y = pk2(a2, a3); *ap = w; }
            if (br == 1) { ss += shx(ss, 32); ss += shx(ss, 1); ss += shx(ss, 2);
                if (lane == (lane & 28)) ((LAS float*)(lds + NS_SS))[g * 64 + tl] = ss; }
        }
        __syncthreads();
        { const int tid = tid_of(wave);
          const LAS float* ssq = (const LAS float*)(lds + NS_SS); const LAS bf16_t* att = (const LAS bf16_t*)(lds + NS_ATT);
          bf16_t* AB = (bf16_t*)(A.ws + WS_AB);
#pragma unroll
          for (int it = 0; it < 4; ++it) { const int idx = it * NTHREADS + tid; const int row = idx >> 5, c8 = idx & 31;
              const float ri = g == 0 ? 1.0f : __builtin_amdgcn_rsqf((ssq[row] + ssq[64 + row]) * (1.f / 512.f) + EPS_);
              const u32x4 w = *(const LAS u32x4*)(att + row * ATTP + c8 * 8);
              u32x4 o; o.x = pk2(bflo(w.x) * ri, bfhi(w.x) * ri); o.y = pk2(bflo(w.y) * ri, bfhi(w.y) * ri); o.z = pk2(bflo(w.z) * ri, bfhi(w.z) * ri); o.w = pk2(bflo(w.w) * ri, bfhi(w.w) * ri);
              *(u32x4*)(AB + (rowbase + 64 * tile + row) * 1024 + g * 256 + c8 * 8) = o; }
          if (g == 1) {
#pragma unroll
              for (int it = 0; it < 4; ++it) { const int idx = it * NTHREADS + tid; const int row = idx >> 5, c8 = idx & 31;
                  const float ri = __builtin_amdgcn_rsqf((ssq[row] + ssq[64 + row]) * (1.f / 512.f) + EPS_);
                  u32x4* p = (u32x4*)(AB + (rowbase + 64 * tile + row) * 1024 + c8 * 8); const u32x4 w = *p;
                  u32x4 o; o.x = pk2(bflo(w.x) * ri, bfhi(w.x) * ri); o.y = pk2(bflo(w.y) * ri, bfhi(w.y) * ri); o.z = pk2(bflo(w.z) * ri, bfhi(w.z) * ri); o.w = pk2(bflo(w.w) * ri, bfhi(w.w) * ri);
                  *p = o; } }
        }
        __syncthreads();
    }
}

__device__ __forceinline__ void nsa_lut(const Args& A, LAS unsigned char* lds, int tid) {
    LAS float* lut = (LAS float*)(lds + NS_LUT);
    for (int i = tid; i < 8 * LUTN; i += NTHREADS) { const int h = i / LUTN, d = i % LUTN;
        int bk; if (d < 16) bk = d; else if (d >= 128) bk = 31; else { bk = 16 + (int)(logf((float)d * (1.0f / 16.0f)) / 2.0794415416798357f * 16.0f); bk = bk > 31 ? 31 : bk; }
        lut[i] = A.in[I_RELB][bk * 8 + h] * LOG2E_; }
    __syncthreads();
}

#define XB_TMO      128
#define XB_XCNT(j)  (256  + 64 * (j))
#define XB_XSUB(j)  (1280 + 64 * (j))
#define XB_XGEN(j)  (2304 + 64 * (j))
#define XB_TOP      3328
#define XB_TOPGEN   3392
#define XCD_BAR_WORDS 3456
#define XB_SPIN_CAP (1u << 20)
__device__ __forceinline__ unsigned xb_ld(unsigned* p)              { return __hip_atomic_load(p, __ATOMIC_RELAXED, __HIP_MEMORY_SCOPE_AGENT); }
__device__ __forceinline__ unsigned xb_add(unsigned* p, unsigned v) { return __hip_atomic_fetch_add(p, v, __ATOMIC_RELAXED, __HIP_MEMORY_SCOPE_AGENT); }
__device__ __forceinline__ unsigned xb_xcc_id() { return (unsigned)__builtin_amdgcn_s_getreg((3 << 11) | 20) & 0xFu; }
#define XB_SPIN(cond, bar) do { unsigned _sp = 0; while (cond) { __builtin_amdgcn_s_sleep(1); \
    if ((++_sp & 255u) == 0u) { if (xb_ld(&(bar)[XB_TMO])) break; if (_sp > XB_SPIN_CAP) { atomicAdd(&(bar)[XB_TMO], 1u); break; } } } } while (0)
struct XcdBarrier { unsigned* bar; unsigned x; volatile LAS unsigned* st; };
__device__ __forceinline__ XcdBarrier xcd_barrier_post(unsigned* bar, volatile LAS unsigned* st, bool leader) {
    XcdBarrier b; b.bar = bar; b.x = xb_xcc_id(); b.st = st;
    if (leader) (void)xb_add(&bar[XB_XCNT(b.x)], 1u);
    return b;
}
__device__ __forceinline__ void xcd_barrier_complete(unsigned* bar, unsigned x, unsigned& nloc, unsigned& nx) {
    const unsigned G = gridDim.x * gridDim.y * gridDim.z;
    unsigned sum, cnt, mine, sp = 0u;
    for (;;) {
        sum = 0u; cnt = 0u; mine = 0u;
#pragma unroll
        for (unsigned j = 0; j < 16; ++j) { const unsigned c = xb_ld(&bar[XB_XCNT(j)]); sum += c; cnt += (c > 0u) ? 1u : 0u; mine = (j == x) ? c : mine; }
        if (sum == G) break;
        __builtin_amdgcn_s_sleep(1);
        if ((++sp & 255u) == 0u) { if (xb_ld(&bar[XB_TMO])) break; if (sp > XB_SPIN_CAP) { atomicAdd(&bar[XB_TMO], 1u); break; } }
    }
    nloc = mine > 0u ? mine : 1u; nx = cnt > 0u ? cnt : 1u;
}
__device__ __forceinline__ void xcd_barrier(const XcdBarrier& b, bool leader) {
    asm volatile("s_waitcnt vmcnt(0)" ::: "memory");
    __syncthreads();
    if (leader) {
        unsigned* bar = b.bar;
        __builtin_amdgcn_s_waitcnt(0);
        unsigned nloc = b.st[0], nx = b.st[1];
        if (nloc == 0u) { xcd_barrier_complete(bar, b.x, nloc, nx); b.st[0] = nloc; b.st[1] = nx; }
        const unsigned old = xb_add(&bar[XB_XSUB(b.x)], 1u);
        const unsigned gen = old / nloc;
        if (old + 1u == (gen + 1u) * nloc) {
            __builtin_amdgcn_fence(__ATOMIC_RELEASE, "agent");
            asm volatile("s_waitcnt vmcnt(0)" ::: "memory");
            const unsigned og = xb_add(&bar[XB_TOP], 1u);
            __builtin_amdgcn_fence(__ATOMIC_ACQUIRE, "agent");
            const unsigned tg = og / nx;
            if (og + 1u == (tg + 1u) * nx) xb_add(&bar[XB_TOPGEN], 1u);
            else XB_SPIN(xb_ld(&bar[XB_TOPGEN]) == tg, bar);
            xb_add(&bar[XB_XGEN(b.x)], 1u);
            asm volatile("s_waitcnt vmcnt(0)" ::: "memory");
        } else {
            __builtin_amdgcn_fence(__ATOMIC_ACQUIRE, "agent");
            XB_SPIN(xb_ld(&bar[XB_XGEN(b.x)]) == gen, bar);
            asm volatile("s_waitcnt vmcnt(0)" ::: "memory");
        }
    }
    __syncthreads();
}

constexpr int NPH = 1 + 9 * NL_;
#ifndef PH_MASK
#define PH_MASK 0xFFFF
#endif
#define PHON(k) (((PH_MASK) >> (k)) & 1)
#ifndef REPEAT_MASK
#define REPEAT_MASK 0
#endif
__global__ void __launch_bounds__(NTHREADS, 2) trunk_fwd(Args args) {
    extern __shared__ __attribute__((aligned(16))) unsigned char lds_raw[];
    LAS unsigned char* lds = (LAS unsigned char*)lds_raw;
    cg::grid_group grid = cg::this_grid();
    const int G = gridDim.x;
    LAS unsigned char* xl = lds + RING_BYTES;
    volatile LAS unsigned* bst = (volatile LAS unsigned*)(lds + LDS_BYTES - 16);
    const int wv_ = __builtin_amdgcn_readfirstlane(threadIdx.x >> 6);
    if (threadIdx.x < 4) bst[threadIdx.x] = 0u;
    __syncthreads();
    XcdBarrier xbar; xbar.bar = (unsigned*)args.ws; xbar.x = 0; xbar.st = bst;

    for (int ph = args.ph_lo; ph < args.ph_hi; ++ph) {
#define PH_IDS() const int tid = tid_of(wv_); const int lane = tid & 63, wave = wv_; (void)lane; (void)wave
        int c = blockIdx.x; asm volatile("" : "+s"(c));
        Args A = args; { size_t z_ = 0; asm volatile("" : "+s"(z_)); A.ws = args.ws + z_; A.out = args.out + z_; }
        unsigned char* ws = A.ws;
        bf16_t* HB = (bf16_t*)(ws + WS_HB); float* RS = (float*)(ws + WS_RS);
        if (ph == 0) { PH_IDS(); if (blockIdx.x == 0) { for (int i = tid; i < 16384; i += NTHREADS) ((unsigned*)args.ws)[i] = 0u; }
            if (PHON(0)) prologue_phase(A, lds, tid, wave, lane); }
        else {
            const int l = (ph - 1) / 9, si_ = (ph - 1) % 9, sp = si_ < 6 ? si_ : si_ + 1;
            unsigned char* wl = ws + WS_W + (size_t)l * WL_STRIDE;
            const int nrep = ((REPEAT_MASK >> sp) & 1) ? 2 : 1;
#pragma unroll 1
            for (int rep = 0; rep < nrep; ++rep) {
            if (rep) grid.sync();
            int nplain = 0;
            if (sp == 0) {
                pg8::Gemm g{HB, (const bf16_t*)(wl + W_INA), 1024, 1024, 1024}; pg8::GenOrder S; S.kind = 0; S.t.init(T_, 2048, 1024, 1024, G, c);
                pg8::EpiG1 E{(bf16_t*)(ws + WS_QB), (bf16_t*)(ws + WS_KP), (float*)(ws + WS_GATES), (bf16_t*)(ws + WS_YG), (bf16_t*)(ws + WS_XR), RS, (bf16_t*)(ws + WS_KF)};
                { PH_IDS(); if (PHON(1)) pg8::gemm_phase<false>(lds, xl, g, S, E, tid); }
                nplain = 1;
            } else if (sp == 1) { PH_IDS();
                if (PHON(2)) { int rnd = 0, it = c; do { lru_item_1p(A, l, it >> 7, (G == 256 && (rnd & 1)) ? 127 - (it & 127) : (it & 127), lds, wave); it += G; ++rnd; } while (it < 512); }
                __syncthreads();
                if (PHON(8)) for (int it = c; it < 128; it += G) compress_item(A, l, it, lds, wave);
                __syncthreads();
                nplain = (l == 0) ? 4 : 0;
            } else if (sp == 2) { PH_IDS();
#ifndef LRU2_REP
#define LRU2_REP 1
#endif
#ifndef NSA_REP
#define NSA_REP 1
#endif
#ifndef NSA_VARIANT
#define NSA_VARIANT 0
#endif
                if (wave >= 4) __builtin_amdgcn_s_setprio(1);
                if (PHON(4)) nsa_lut(A, lds, tid);
                if (NSA_REP > 1) for (int pr = c; pr < 256; pr += G) { const int b = pr >> 6, p = pr & 63; nsa_item<NSA_VARIANT>(A, l, b, 127 - p, lds, wave); nsa_item<NSA_VARIANT>(A, l, b, p, lds, wave); }
                if (PHON(4)) for (int pr = c; pr < 256; pr += G) { const int b = (G == 256) ? (pr & 7) >> 1 : pr >> 6, p = (G == 256) ? ((pr & 1) << 5) + (pr >> 3) : pr & 63;
                    nsa_item<0>(A, l, b, 127 - p, lds, wave); nsa_item<0>(A, l, b, p, lds, wave); }
                __builtin_amdgcn_s_setprio(0);
            } else if (sp == 3 || sp == 7) {
                pg8::Gemm g; pg8::ResidOrder S; S.kind = (G == 256) ? 0 : 3; pg8::EpiResid E; E.XB = HB; E.SL = (unsigned long long*)(ws + WS_SLOT); E.RS4 = RS; E.out_f32 = nullptr; E.eps = EPS_;
                if (sp == 3) { g = pg8::Gemm{(const bf16_t*)(ws + WS_AB), (const bf16_t*)(wl + W_OUT), 1024, 1024, 1024}; E.gpost = A.in[I_LN_MIX_POST] + l * D_; E.tag = 1u + 3u * l; }
                else { g = pg8::Gemm{(const bf16_t*)(ws + WS_CO), (const bf16_t*)(wl + W_XO), 1024, 1024, 1024}; E.gpost = A.in[I_LN_X_POST] + l * D_; E.tag = 2u + 3u * l; }
                S.t.init(T_, 1024, g.lda, g.ldb, G, c);
                PH_IDS(); if (PHON(5)) pg8::gemm_phase<false>(lds, xl, g, S, E, tid);
            } else if (sp == 9) {
                pg8::Gemm g{(const bf16_t*)(ws + WS_U), (const bf16_t*)(wl + W_2), FF_ / 2, FF_ / 2, FF_ / 2}; pg8::ResidOrder S; S.kind = (G == 256) ? 0 : 3;
                pg8::EpiResid E; E.XB = HB; E.SL = (unsigned long long*)(ws + WS_SLOT); E.RS4 = RS; E.out_f32 = (l + 1 == NL_) ? A.out : nullptr; E.gpost = A.in[I_LN_MLP_POST] + l * D_; E.tag = 3u + 3u * l;
                E.eps = EPS_ * (U8_SCALE * W8_SCALE) * (U8_SCALE * W8_SCALE);
                S.t.init(T_, 1024, g.lda, g.ldb, G, c);
                PH_IDS(); if (PHON(5)) pg8::gemm_phase<true>(lds, xl, g, S, E, tid);
            } else if (sp == 5) {
                pg8::Gemm g{(const bf16_t*)(ws + WS_CQ), (const bf16_t*)(ws + WS_CK) + (size_t)l * 1024 * 1024, 1024, 1024, 256}; pg8::GenOrder S; S.kind = 4; S.t.init(T_, 1024, 1024, 1024, G, c);
                pg8::EpiSoftmax E{(bf16_t*)(ws + WS_PP)}; PH_IDS(); if (PHON(6)) pg8::gemm_phase<false>(lds, xl, g, S, E, tid);
                nplain = 1;
            } else nplain = 1;
#pragma unroll 1
            for (int q = 0; q < nplain; ++q) {
                pg8::Gemm g; pg8::GenOrder S; S.kind = 0; pg8::EpiBf16 E; E.row_limit = 1 << 30; E.act = 0; E.rs = RS; E.rs_mode = 0; E.vf = nullptr;
                if (sp == 0 && q == 0) { g = pg8::Gemm{(const bf16_t*)(wl + W_INV), HB, 1024, 1024, 1024}; S.t.init(512, T_, 1024, 1024, G, c); E.O = (bf16_t*)(ws + WS_VT); E.ldc = T_; E.row_limit = 384; E.rs_mode = 2; E.vf = (bf16_t*)(ws + WS_VF); }
                else if (sp == 1) { const int ll = q >> 1; unsigned char* w2 = ws + WS_W + (size_t)ll * WL_STRIDE; S.t.init(1024, 1024, 1024, 1024, G, (c + 4 * G - 128 - 16 * q) % G); E.ldc = 1024;
                    if ((q & 1) == 0) { g = pg8::Gemm{(const bf16_t*)(ws + WS_MNB), (const bf16_t*)(w2 + W_XK), 1024, 1024, 1024}; E.O = (bf16_t*)(ws + WS_CK) + (size_t)ll * 1024 * 1024; }
                    else { g = pg8::Gemm{(const bf16_t*)(w2 + W_XV), (const bf16_t*)(ws + WS_MNB), 1024, 1024, 1024}; E.O = (bf16_t*)(ws + WS_CVT) + (size_t)ll * 1024 * 1024; } }
                else if (sp == 4) { g = pg8::Gemm{HB, (const bf16_t*)(wl + W_XQ), 1024, 1024, 1024}; S.t.init(T_, 1024, 1024, 1024, G, c); E.O = (bf16_t*)(ws + WS_CQ); E.ldc = 1024; E.rs_mode = 1; }
                else if (sp == 5) { g = pg8::Gemm{(const bf16_t*)(ws + WS_PP), (const bf16_t*)(ws + WS_CVT) + (size_t)l * 1024 * 1024, 1024, 1024, 256}; S.kind = 5; S.t.init(T_, 1024, 1024, 1024, G, c); E.O = (bf16_t*)(ws + WS_CO); E.ldc = 1024; }
                else { g = pg8::Gemm{HB, (const bf16_t*)(wl + W_1), 1024, 1024, 1024}; S.t.init(T_, FF_, 1024, 1024, G, c); E.O = (bf16_t*)(ws + WS_U); E.ldc = FF_; E.act = 2; E.rs_mode = 1; }
                PH_IDS(); if (PHON(7)) pg8::gemm_phase<false>(lds, xl, g, S, E, tid);
            }
            }
        }
        const bool local_seam = ph > 0 && ((ph - 1) % 9) == 4;
        if (ph + 1 < args.ph_hi && !local_seam) { const bool leader = tid_of(wv_) == 0; if (ph == 0) { grid.sync(); xbar = xcd_barrier_post((unsigned*)args.ws, bst, leader); } else xcd_barrier(xbar, leader); }
    }
}

#ifndef N_LAUNCH_MODE
#define N_LAUNCH_MODE 1
#endif
extern "C" void kernel_launch(void* const* d_in, const int* in_sizes, int n_in, void* d_out, int out_size, void* d_ws, size_t ws_size, hipStream_t stream) {
    static int grid = 0;
    if (grid == 0) {
        if (n_in != 30 || out_size != T_ * D_ || ws_size < WS_END) { fprintf(stderr, "kernel_launch: unexpected problem (n_in %d, out %d, ws %zu)\n", n_in, out_size, ws_size); grid = -1; return; }
        int dev = 0, cus = 0, per_cu = 0;
        (void)hipGetDevice(&dev); (void)hipDeviceGetAttribute(&cus, hipDeviceAttributeMultiprocessorCount, dev);
        if (hipFuncSetAttribute((const void*)trunk_fwd, hipFuncAttributeMaxDynamicSharedMemorySize, LDS_BYTES) != hipSuccess) { fprintf(stderr, "kernel_launch: hipFuncSetAttribute failed\n"); grid = -1; return; }
        if (hipOccupancyMaxActiveBlocksPerMultiprocessor(&per_cu, (const void*)trunk_fwd, NTHREADS, LDS_BYTES) != hipSuccess || per_cu < 1) { fprintf(stderr, "kernel_launch: occupancy query says %d\n", per_cu); per_cu = 1; }
        (void)hipGetLastError();
        grid = cus;
        if (grid > 256) grid = 256;
        if (grid != 256) grid &= ~3;
    }
    if (grid < 0) return;
    Args a{};
    for (int i = 0; i < 30; ++i) a.in[i] = (const float*)d_in[i];
    a.out = (float*)d_out; a.ws = (unsigned char*)d_ws;
#if N_LAUNCH_MODE == 1
    a.ph_lo = 0; a.ph_hi = NPH;
    { void* kargs[] = {&a};
      hipError_t e = hipLaunchCooperativeKernel((const void*)trunk_fwd, dim3(grid), dim3(NTHREADS), kargs, LDS_BYTES, stream);
      if (e != hipSuccess) fprintf(stderr, "kernel_launch: cooperative launch failed: %s (grid %d)\n", hipGetErrorString(e), grid); }
#else
    for (int ph = 0; ph < NPH; ++ph) { a.ph_lo = ph; a.ph_hi = ph + 1; void* kargs[] = {&a};
        hipError_t e = hipLaunchCooperativeKernel((const void*)trunk_fwd, dim3(grid), dim3(NTHREADS), kargs, LDS_BYTES, stream);
        if (e != hipSuccess) { fprintf(stderr, "kernel_launch: cooperative launch %d failed: %s (grid %d)\n", ph, hipGetErrorString(e), grid); break; } }
#endif
}
```

```cpp
#include <hip/hip_runtime.h>
#include <hip/hip_cooperative_groups.h>
#include <cstdio>
#include <cstdint>
namespace cg = cooperative_groups;

#define LAS __attribute__((address_space(3)))
typedef unsigned short bf16_t;
typedef short bf16x8 __attribute__((ext_vector_type(8)));
typedef short s16x4 __attribute__((ext_vector_type(4)));
typedef float f32x2 __attribute__((ext_vector_type(2)));
typedef float f32x4 __attribute__((ext_vector_type(4)));
typedef float f32x16 __attribute__((ext_vector_type(16)));
typedef unsigned u32x2 __attribute__((ext_vector_type(2)));
typedef unsigned u32x4 __attribute__((ext_vector_type(4)));
typedef int i32x4 __attribute__((ext_vector_type(4)));
typedef int i32x8 __attribute__((ext_vector_type(8)));

constexpr int NB_ = 4, S_ = 8192, T_ = NB_ * S_, D_ = 1024, NL_ = 2, FF_ = 4096, MEM_ = 256;
constexpr int INC_ = 2328;
constexpr float EPS_ = 1e-6f, NEG_ = -1e30f, LOG2E_ = 1.4426950408889634f;
constexpr float C2_ = 0.125f * LOG2E_, XC2_ = 0.0625f * LOG2E_;

constexpr size_t MiB = 1u << 20;
constexpr size_t WS_PEP = 1 * MiB;
constexpr size_t WS_W = 2 * MiB, WL_STRIDE = 33 * MiB;
constexpr size_t W_INA = 0, W_INV = 4 * MiB, W_OUT = 5 * MiB, W_XQ = 7 * MiB, W_XK = 9 * MiB, W_XV = 11 * MiB, W_XO = 13 * MiB,
                 W_1 = 15 * MiB, W_2 = 23 * MiB, W_CK = 31 * MiB, W_CV = 31 * MiB + 512 * 1024, W_A = 32 * MiB, W_X = 32 * MiB + 65536;
constexpr size_t WS_MNB = 68 * MiB;
constexpr size_t WS_CK = 70 * MiB;
constexpr size_t WS_CVT = 74 * MiB;
constexpr size_t WS_KCB = 78 * MiB;
constexpr size_t WS_VCT = 79 * MiB;
constexpr size_t WS_AGG = 80 * MiB;
constexpr size_t WS_RS = 82 * MiB;
constexpr size_t WS_HB = 84 * MiB;
constexpr size_t WS_SLOT = 148 * MiB;
constexpr size_t WS_AGG2 = 150 * MiB;
constexpr size_t WS_U = 212 * MiB;
constexpr size_t WS_QB = WS_U;
constexpr size_t WS_KP = WS_U + 32 * MiB;
constexpr size_t WS_VT = WS_U + 56 * MiB;
constexpr size_t WS_GATES = WS_U + 88 * MiB;
constexpr size_t WS_YG = WS_U + 92 * MiB;
constexpr size_t WS_XR = WS_U + 124 * MiB;
constexpr size_t WS_AB = WS_U + 156 * MiB;
constexpr size_t WS_KF = WS_U + 220 * MiB;
constexpr size_t WS_VF = WS_U + 228 * MiB;
constexpr size_t WS_CQ = WS_U;
constexpr size_t WS_PP = WS_U + 64 * MiB;
constexpr size_t WS_CO = WS_U + 128 * MiB;
constexpr size_t WS_END = WS_U + 256 * MiB;

constexpr float U8_SCALE = 8.0f  , W8_SCALE = 1024.0f;
constexpr int LDS_BYTES = 147456;
constexpr int RING_BYTES = 131072;
constexpr int NTHREADS = 512;

__device__ __forceinline__ unsigned f2bf(float f) { unsigned u = __builtin_bit_cast(unsigned, f); return (u + 0x7fffu + ((u >> 16) & 1u)) >> 16; }
__device__ __forceinline__ unsigned pk2(float lo, float hi) { unsigned r; asm("v_cvt_pk_bf16_f32 %0, %1, %2" : "=v"(r) : "v"(lo), "v"(hi)); return r; }
__device__ __forceinline__ unsigned cvt_pk_bf16(float lo, float hi) { unsigned r; asm("v_cvt_pk_bf16_f32 %0, %1, %2" : "=v"(r) : "v"(lo), "v"(hi)); return r; }
__device__ __forceinline__ float bflo(unsigned w) { return __builtin_bit_cast(float, w << 16); }
__device__ __forceinline__ float bfhi(unsigned w) { return __builtin_bit_cast(float, w & 0xffff0000u); }
__device__ __forceinline__ float bf2f(bf16_t h) { return __builtin_bit_cast(float, (unsigned)h << 16); }
__device__ __forceinline__ float ex2(float x) { return __builtin_amdgcn_exp2f(x); }
__device__ __forceinline__ float rcp(float x) { return __builtin_amdgcn_rcpf(x); }
__device__ __forceinline__ float sigmoidf_(float x) { return rcp(1.0f + ex2(-LOG2E_ * x)); }
__device__ __forceinline__ float gelu_tanh(float x) { const float z = x + 0.044715f * x * x * x; return x * rcp(1.0f + ex2(-2.302208198f * z)); }
__device__ __forceinline__ float rs_of(f32x4 p) { return __builtin_amdgcn_rsqf(((p.x + p.y) + (p.z + p.w)) * (1.f / D_) + EPS_); }
__device__ __forceinline__ int crow(int r, int hi) { return (r & 3) + 8 * (r >> 2) + 4 * hi; }
__device__ __forceinline__ int lane_v() { int l; asm volatile("v_mbcnt_lo_u32_b32 %0, -1, 0\n\tv_mbcnt_hi_u32_b32 %0, -1, %0" : "=v"(l)); return l; }
__device__ __forceinline__ int tid_of(int wave) { return (wave << 6) | lane_v(); }
__device__ __forceinline__ float shx(float v, int m) { return __int_as_float(__builtin_amdgcn_ds_bpermute((lane_v() ^ m) << 2, __float_as_int(v))); }
__device__ __forceinline__ int shup8(int v, int d) { const int s = lane_v(); return __builtin_amdgcn_ds_bpermute((((s & 7) >= d) ? s - d : s) << 2, v); }
__device__ __forceinline__ float wave_sum(float v) {
    const int l_ = lane_v();
#pragma unroll
    for (int o = 1; o < 64; o <<= 1) v += __int_as_float(__builtin_amdgcn_ds_bpermute((l_ ^ o) << 2, __float_as_int(v)));
    return v;
}
#define LDS_WAIT() asm volatile("s_waitcnt lgkmcnt(0)" ::: "memory")
#define VM_WAIT() asm volatile("s_waitcnt vmcnt(0)" ::: "memory")

namespace pg8 {
constexpr int BM = 256, BK = 64, HALF = 128, HTB = HALF * BK * 2, STAGE_BYTES = 8 * HTB, NXCD = 8, WGM = 8;
__device__ __forceinline__ int lds_byte(int r, int c) { const int st = (r >> 4) * 2 + (c >> 5), rr = r & 15, cc = c & 31, ob = rr * 64 + cc * 2; return st * 1024 + (ob ^ (((ob >> 9) & 1) << 5)); }
__device__ __forceinline__ void stage_rc(int b, int& R, int& C) { const int st = b / 1024, sb = b % 1024, swz = sb ^ (((sb >> 9) & 1) << 5); R = (st >> 1) * 16 + swz / 64; C = (st & 1) * 32 + (swz % 64) / 2; }
__device__ __forceinline__ int perm32(int rho) { const int n = rho >> 4, i = rho & 15; return 8 * (i >> 2) + 4 * n + (i & 3); }

struct Unit { int pm, pn; long aoff, boff; };
struct Gemm { const bf16_t* A; const bf16_t* Bt; int lda, ldb, K; };

struct TileOrder {
    int nM, nN, nwg, G, c; long astep, bstep;
    __device__ void init(int M, int N, int lda, int ldb, int G_, int c_) { nM = M / BM; nN = N / BM; nwg = nM * nN; G = G_; c = c_; astep = (long)BM * lda * 2; bstep = (long)BM * ldb * 2; }
    __device__ bool next(int i, Unit& u) const {
        const long L = (long)i * G + c; if (L >= nwg) return false;
        int wgid = (int)L; { const int q = nwg / NXCD, r = nwg % NXCD, xcd = wgid % NXCD, off = wgid / NXCD; wgid = (xcd < r ? xcd * (q + 1) : r * (q + 1) + (xcd - r) * q) + off; }
        const int nig = WGM * nN, gid = wgid / nig, fm = gid * WGM, gsz = (nM - fm) < WGM ? (nM - fm) : WGM;
        u.pm = fm + ((wgid % nig) % gsz); u.pn = (wgid % nig) / gsz; u.aoff = u.pm * astep; u.boff = u.pn * bstep; return true;
    }
};
struct ResidOrder {
    int kind; TileOrder t;
    __device__ bool next(int i, Unit& u) const {
        if (kind == 0) return t.next(i, u);
        const long L = (long)i * t.G + t.c; if (L >= 512) return false;
        u.pm = (int)L >> 2; u.pn = (int)L & 3; u.aoff = u.pm * t.astep; u.boff = u.pn * t.bstep; return true;
    }
};
struct GenOrder {
    int kind; TileOrder t;
    __device__ bool next(int i, Unit& u) const {
        if (kind == 0) return t.next(i, u);
        if (kind >= 4) { if (!t.next(i, u)) return false;
            const int h = u.pn, pmg = u.pm, b = pmg >> 5; u.aoff = ((long)pmg * 256 * 1024 + h * 256) * 2;
            u.boff = kind == 4 ? ((long)b * 256 * 1024 + h * 256) * 2 : ((long)h * 256 * 1024 + b * 256) * 2; return true; }
        const long L = (long)i * t.G + t.c; if (L >= 512) return false;
        const int h = (int)L & 3, pmg = (int)L >> 2, b = pmg >> 5;
        u.pm = pmg; u.pn = h; u.aoff = ((long)pmg * 256 * 1024 + h * 256) * 2;
        u.boff = kind == 1 ? ((long)b * 256 * 1024 + h * 256) * 2 : ((long)h * 256 * 1024 + b * 256) * 2; return true;
    }
};

struct EpiBf16 {
    static constexpr bool NEEDS_LDS = false, RS_PREFETCH = true;
    bf16_t* O; long ldc; int row_limit; int act; const float* rs; int rs_mode; bf16_t* vf;
    __device__ __forceinline__ void operator()(f32x4 (&acc)[2][2][4][2], const Unit& u, int wr, int wc, int fr, int fq, LAS unsigned char* xl) const {
        asm volatile("" : "+v"(fr), "+v"(fq));
        const int row0 = u.pm * BM + wr * 64 + fr; const int col0 = u.pn * BM + wc * 32 + 8 * fq;
        float rs8[2][4];
#pragma unroll
        for (int ai = 0; ai < 2; ++ai)
#pragma unroll
            for (int m = 0; m < 4; ++m) rs8[ai][m] = rs_mode == 1 ? rs_of(*(const LAS f32x4*)(xl + (wr * 64 + fr + ai * HALF + m * 16) * 16)) : 1.0f;
        if (act == 2) {
            const int odd = fq & 1;
            unsigned char* lane0 = (unsigned char*)O + (size_t)(row0 + odd * 16) * ldc + col0 - odd * 8;
#pragma unroll
            for (int ai = 0; ai < 2; ++ai)
#pragma unroll
                for (int mp = 0; mp < 2; ++mp)
#pragma unroll
                    for (int bj = 0; bj < 2; ++bj) { unsigned pq[2][2];
#pragma unroll
                        for (int k = 0; k < 2; ++k) { const int m = 2 * mp + k; const float r2 = rs8[ai][m] * 2.8284271f; f32x4 z0 = acc[ai][bj][m][0] * r2, z1 = acc[ai][bj][m][1] * r2;
#pragma unroll
                            for (int e = 0; e < 4; ++e) { z0[e] = __builtin_amdgcn_fmed3f(z0[e], 0.f, 21.16f); z1[e] = __builtin_amdgcn_fmed3f(z1[e], 0.f, 21.16f); }
                            z0 *= z0; z1 *= z1;
                            int p0 = __builtin_amdgcn_cvt_pk_fp8_f32(z0[0], z0[1], 0, false); p0 = __builtin_amdgcn_cvt_pk_fp8_f32(z0[2], z0[3], p0, true);
                            int p1 = __builtin_amdgcn_cvt_pk_fp8_f32(z1[0], z1[1], 0, false); p1 = __builtin_amdgcn_cvt_pk_fp8_f32(z1[2], z1[3], p1, true);
                            pq[k][0] = (unsigned)p0; pq[k][1] = (unsigned)p1; }
                        const auto s0 = __builtin_amdgcn_permlane16_swap(pq[0][0], pq[1][0], false, false), s1 = __builtin_amdgcn_permlane16_swap(pq[0][1], pq[1][1], false, false);
                        *(u32x4*)(lane0 + (size_t)(ai * HALF + mp * 32) * ldc + bj * HALF) = (u32x4){s0[0], s1[0], s0[1], s1[1]}; }
            return; }
        if (act == 0 && rs_mode != 2 && vf == nullptr && row_limit >= (1 << 30)) {
#pragma unroll
            for (int ai = 0; ai < 2; ++ai)
#pragma unroll
                for (int m = 0; m < 4; ++m) { const float rsr = rs8[ai][m]; bf16_t* rowp = O + (size_t)(row0 + ai * HALF + m * 16) * ldc + col0;
#pragma unroll
                    for (int bj = 0; bj < 2; ++bj) { const f32x4 v0 = acc[ai][bj][m][0] * rsr, v1 = acc[ai][bj][m][1] * rsr;
                        u32x4 w; w.x = cvt_pk_bf16(v0[0], v0[1]); w.y = cvt_pk_bf16(v0[2], v0[3]); w.z = cvt_pk_bf16(v1[0], v1[1]); w.w = cvt_pk_bf16(v1[2], v1[3]);
                        *(u32x4*)(rowp + bj * HALF) = w; } }
            return; }
#pragma unroll
        for (int bj = 0; bj < 2; ++bj) { f32x4 cs0 = (f32x4){1.f, 1.f, 1.f, 1.f}, cs1 = cs0;
            if (rs_mode == 2) {
#pragma unroll
                for (int e = 0; e < 4; ++e) { cs0[e] = rs_of(((const f32x4*)rs)[col0 + bj * HALF + e]); cs1[e] = rs_of(((const f32x4*)rs)[col0 + bj * HALF + 4 + e]); } }
#pragma unroll
            for (int ai = 0; ai < 2; ++ai)
#pragma unroll
                for (int m = 0; m < 4; ++m) { const int row = row0 + ai * HALF + m * 16; if (row >= row_limit) continue; bf16_t* rowp = O + (size_t)row * ldc + col0;
                    const float rsr = rs8[ai][m];
                    f32x4 v0 = acc[ai][bj][m][0] * rsr, v1 = acc[ai][bj][m][1] * rsr;
                    if (rs_mode == 2) { v0 *= cs0; v1 *= cs1; }
                    if (act >= 1) {
#pragma unroll
                        for (int e = 0; e < 4; ++e) { const float a = fmaxf(v0[e], 0.f), b = fmaxf(v1[e], 0.f); v0[e] = a * a; v1[e] = b * b; } }
                    u32x4 w; w.x = cvt_pk_bf16(v0[0], v0[1]); w.y = cvt_pk_bf16(v0[2], v0[3]); w.z = cvt_pk_bf16(v1[0], v1[1]); w.w = cvt_pk_bf16(v1[2], v1[3]);
                    *(u32x4*)(rowp + bj * HALF) = w;
                    if (vf && row >= 128 && row < 256) { const int g = (row >> 6) & 1, d = row & 63, col = col0 + bj * HALF, k0 = col & 63;
                        bf16_t* p = vf + ((size_t)g * (T_ / 64) + (col >> 6)) * 4096 + (((((k0 >> 5) * 2 + ((k0 >> 4) & 1)) * 2 + (d >> 5)) * 2) * 32 + (d & 31)) * 8 + 4 * ((k0 >> 3) & 1);
                        const auto s0 = __builtin_amdgcn_permlane16_swap(w.x, w.z, false, false), s1 = __builtin_amdgcn_permlane16_swap(w.y, w.w, false, false);
                        *(u32x4*)(p + ((fq & 1) ? 252 : 0)) = (u32x4){s0[0], s1[0], s0[1], s1[1]}; } } }
    }
};
struct EpiG1 {
    static constexpr bool NEEDS_LDS = false, RS_PREFETCH = true;
    bf16_t* QB; bf16_t* KP; float* GATES; bf16_t* YG; bf16_t* XR; const float* rs; bf16_t* KF;
    __device__ __forceinline__ void operator()(f32x4 (&acc)[2][2][4][2], const Unit& u, int wr, int wc, int fr, int fq, LAS unsigned char* xl) const {
        asm volatile("" : "+v"(fr), "+v"(fq));
        const int row0 = u.pm * BM + wr * 64 + fr; const int pn = u.pn; const int cl0 = wc * 32 + 8 * fq;
        float rs8[2][4];
#pragma unroll
        for (int ai = 0; ai < 2; ++ai)
#pragma unroll
            for (int m = 0; m < 4; ++m) rs8[ai][m] = rs_of(*(const LAS f32x4*)(xl + (wr * 64 + fr + ai * HALF + m * 16) * 16));
#pragma unroll
        for (int ai = 0; ai < 2; ++ai)
#pragma unroll
            for (int m = 0; m < 4; ++m) { const size_t row = (size_t)(row0 + ai * HALF + m * 16); const float rsr = rs8[ai][m];
#pragma unroll
                for (int bj = 0; bj < 2; ++bj) { f32x4 v0 = acc[ai][bj][m][0] * rsr, v1 = acc[ai][bj][m][1] * rsr;
                    bf16_t* dst = nullptr;
                    if (pn < 2) dst = QB + row * 512 + pn * 256 + bj * 128 + cl0;
                    else if (pn == 2 || (pn == 3 && bj == 0)) { const int plane = (pn == 2) ? bj : 2; const int g = cl0 >> 6, d = cl0 & 63; dst = KP + ((size_t)(plane * 2 + g) * T_ + row) * 64 + d; }
                    else if (pn == 3) {
                        if (cl0 < 24) { float* gp = GATES + row * 24 + cl0; f32x4 a, b;
#pragma unroll
                            for (int e = 0; e < 4; ++e) { a[e] = sigmoidf_(v0[e]); b[e] = sigmoidf_(v1[e]); }
                            *(f32x4*)gp = a; *(f32x4*)(gp + 4) = b; }
                        continue; }
                    else if (pn < 6) { dst = YG + row * 512 + (pn - 4) * 256 + bj * 128 + cl0;
#pragma unroll
                        for (int e = 0; e < 4; ++e) { v0[e] = gelu_tanh(v0[e]); v1[e] = gelu_tanh(v1[e]); } }
                    else dst = XR + row * 512 + (pn - 6) * 256 + bj * 128 + cl0;
                    u32x4 w; w.x = cvt_pk_bf16(v0[0], v0[1]); w.y = cvt_pk_bf16(v0[2], v0[3]); w.z = cvt_pk_bf16(v1[0], v1[1]); w.w = cvt_pk_bf16(v1[2], v1[3]);
                    *(u32x4*)dst = w;
                    if (pn == 2 && bj == 1) { const int g = cl0 >> 6, d = cl0 & 63, key = (int)row & 63;
                        *(u32x4*)(KF + ((size_t)g * (T_ / 64) + (row >> 6)) * 4096 + ((((key >> 5) * 4 + (d >> 4)) * 2 + ((d >> 3) & 1)) * 32 + (key & 31)) * 8) = w; } } }
    }
};
struct EpiSoftmax {
    static constexpr bool NEEDS_LDS = true, RS_PREFETCH = false;
    bf16_t* P;
    __device__ __forceinline__ void operator()(f32x4 (&acc)[2][2][4][2], const Unit& u, int wr, int wc, int fr, int fq, LAS unsigned char* xl) const {
        asm volatile("" : "+v"(fr), "+v"(fq));
        LAS f32x2* X = (LAS f32x2*)xl;
#pragma unroll
        for (int ai = 0; ai < 2; ++ai)
#pragma unroll
            for (int m = 0; m < 4; ++m) { float mx = NEG_;
#pragma unroll
                for (int bj = 0; bj < 2; ++bj)
#pragma unroll
                    for (int n = 0; n < 2; ++n)
#pragma unroll
                        for (int e = 0; e < 4; ++e) mx = fmaxf(mx, acc[ai][bj][m][n][e]);
                mx = fmaxf(mx, shx(mx, 16)); mx = fmaxf(mx, shx(mx, 32));
                float s = 0.f;
#pragma unroll
                for (int bj = 0; bj < 2; ++bj)
#pragma unroll
                    for (int n = 0; n < 2; ++n)
#pragma unroll
                        for (int e = 0; e < 4; ++e) { const float p = ex2(acc[ai][bj][m][n][e] - mx); acc[ai][bj][m][n][e] = p; s += p; }
                s += shx(s, 16); s += shx(s, 32);
                X[(ai * HALF + wr * 64 + m * 16 + fr) * 4 + wc] = (f32x2){mx, s}; }
        LDS_WAIT(); __builtin_amdgcn_s_barrier(); asm volatile("" ::: "memory");
        const size_t row0 = (size_t)u.pm * BM + wr * 64 + fr; const int col0 = u.pn * BM + wc * 32 + 8 * fq;
#pragma unroll
        for (int ai = 0; ai < 2; ++ai)
#pragma unroll
            for (int m = 0; m < 4; ++m) { const int r = ai * HALF + wr * 64 + m * 16 + fr;
                asm volatile("" ::: "memory");
                const f32x2 a = X[r * 4 + 0], b = X[r * 4 + 1], c = X[r * 4 + 2], d = X[r * 4 + 3];
                const float M = fmaxf(fmaxf(a.x, b.x), fmaxf(c.x, d.x));
                const float Lsum = a.y * ex2(a.x - M) + b.y * ex2(b.x - M) + c.y * ex2(c.x - M) + d.y * ex2(d.x - M);
                const float mine = wc == 0 ? a.x : (wc == 1 ? b.x : (wc == 2 ? c.x : d.x));
                const float f = ex2(mine - M) * rcp(Lsum);
                bf16_t* rowp = P + (row0 + ai * HALF + m * 16) * 1024 + col0;
#pragma unroll
                for (int bj = 0; bj < 2; ++bj) { const f32x4 v0 = acc[ai][bj][m][0] * f, v1 = acc[ai][bj][m][1] * f;
                    u32x4 w; w.x = cvt_pk_bf16(v0[0], v0[1]); w.y = cvt_pk_bf16(v0[2], v0[3]); w.z = cvt_pk_bf16(v1[0], v1[1]); w.w = cvt_pk_bf16(v1[2], v1[3]);
                    *(u32x4*)(rowp + bj * HALF) = w; } }
        LDS_WAIT();
    }
};

struct EpiResid {
    static constexpr bool NEEDS_LDS = true, RS_PREFETCH = false;
    bf16_t* XB; const float* gpost; unsigned long long* SL; float* RS4; float* out_f32; unsigned tag; float eps;
    __device__ __forceinline__ static void reduce8(const float (&s)[8], float (&d)[2]) {
        float c[4];
#pragma unroll
        for (int j = 0; j < 4; ++j) { const auto r = __builtin_amdgcn_permlane32_swap(__float_as_uint(s[2 * j]), __float_as_uint(s[2 * j + 1]), false, false);
            c[j] = __uint_as_float(r[0]) + __uint_as_float(r[1]); }
#pragma unroll
        for (int k = 0; k < 2; ++k) { const auto r = __builtin_amdgcn_permlane16_swap(__float_as_uint(c[2 * k]), __float_as_uint(c[2 * k + 1]), false, false);
            d[k] = __uint_as_float(r[0]) + __uint_as_float(r[1]); }
    }
    __device__ __forceinline__ void operator()(f32x4 (&acc)[2][2][4][2], const Unit& u, int wr, int wc, int, int, LAS unsigned char* xl) const {
        const int tid_ = tid_of(wr * 4 + wc); const int fr = tid_ & 15, fq = (tid_ >> 4) & 3;
        LAS float* X = (LAS float*)xl; LAS float* RY = (LAS float*)(xl + 4096);
        const int lrow0 = wr * 64 + fr, t = wc * 64 + fq * 16 + fr;
        const int xoff = (lrow0 + (((fq & 1) << 1) | (fq >> 1)) * 16) * 4 + wc;
        { float s[8], d[2];
#pragma unroll
          for (int ai = 0; ai < 2; ++ai)
#pragma unroll
            for (int m = 0; m < 4; ++m) { float a = 0.f;
#pragma unroll
                for (int bj = 0; bj < 2; ++bj)
#pragma unroll
                    for (int n = 0; n < 2; ++n)
#pragma unroll
                        for (int e = 0; e < 4; ++e) a = fmaf(acc[ai][bj][m][n][e], acc[ai][bj][m][n][e], a);
                s[ai * 4 + m] = a; }
          reduce8(s, d); X[xoff] = d[0]; X[HALF * 4 + xoff] = d[1]; }
        LDS_WAIT(); __builtin_amdgcn_s_barrier(); asm volatile("" ::: "memory");
        unsigned long long* sl = SL + (size_t)u.pm * 1024 + t;
        if (wr == 0) { const f32x4 v = *(const LAS f32x4*)(X + t * 4); const float s = (v.x + v.y) + (v.z + v.w);
            __hip_atomic_store(sl + u.pn * 256, ((unsigned long long)tag << 32) | (unsigned long long)__builtin_bit_cast(unsigned, s), __ATOMIC_RELAXED, __HIP_MEMORY_SCOPE_AGENT); }
        const int col0 = u.pn * BM + wc * 32 + 8 * fq;
        const size_t tile0 = ((size_t)u.pm * BM + wr * 64) * D_ + u.pn * BM + wc * 32;
        const unsigned vo = (unsigned)(fr * D_ + 8 * fq);
        char* xt = (char*)(XB + tile0);
        u32x4 xw[2][4][2];
#define RESID_LDX(ai, m0, m1) do { _Pragma("unroll") for (int m = m0; m < m1; ++m) _Pragma("unroll") for (int bj = 0; bj < 2; ++bj) \
            xw[ai][m][bj] = *(const u32x4*)(xt + (size_t)(((ai) * HALF + m * 16) * D_ + bj * HALF) * 2 + vo * 2u); } while (0)
        RESID_LDX(0, 0, 4); RESID_LDX(1, 0, 3);
        if (wr == 0) { unsigned long long v0, v1, v2, v3; unsigned sp = 0;
            for (;;) { v0 = __hip_atomic_load(sl, __ATOMIC_RELAXED, __HIP_MEMORY_SCOPE_AGENT); v1 = __hip_atomic_load(sl + 256, __ATOMIC_RELAXED, __HIP_MEMORY_SCOPE_AGENT);
                v2 = __hip_atomic_load(sl + 512, __ATOMIC_RELAXED, __HIP_MEMORY_SCOPE_AGENT); v3 = __hip_atomic_load(sl + 768, __ATOMIC_RELAXED, __HIP_MEMORY_SCOPE_AGENT);
                if (((unsigned)(v0 >> 32) == tag) & ((unsigned)(v1 >> 32) == tag) & ((unsigned)(v2 >> 32) == tag) & ((unsigned)(v3 >> 32) == tag)) break;
                __builtin_amdgcn_s_sleep(1); if (++sp > (1u << 22)) break; }
            const float s = (__builtin_bit_cast(float, (unsigned)v0) + __builtin_bit_cast(float, (unsigned)v1)) + (__builtin_bit_cast(float, (unsigned)v2) + __builtin_bit_cast(float, (unsigned)v3));
            RY[t] = __builtin_amdgcn_rsqf(s * (1.f / D_) + eps); }
        LDS_WAIT(); __builtin_amdgcn_s_barrier(); asm volatile("" ::: "memory");
        RESID_LDX(1, 3, 4);
#undef RESID_LDX
        f32x4 g[2][2]; float sq[8];
#pragma unroll
        for (int bj = 0; bj < 2; ++bj) { g[bj][0] = *(const f32x4*)(gpost + col0 + bj * HALF); g[bj][1] = *(const f32x4*)(gpost + col0 + bj * HALF + 4); }
#pragma unroll
        for (int ai = 0; ai < 2; ++ai)
#pragma unroll
            for (int m = 0; m < 4; ++m) { const float ry = RY[ai * HALF + lrow0 + m * 16]; float s2 = 0.f;
#pragma unroll
                for (int bj = 0; bj < 2; ++bj) { const u32x4 w = xw[ai][m][bj];
                    f32x4 x0 = (f32x4){bflo(w.x), bfhi(w.x), bflo(w.y), bfhi(w.y)}, x1 = (f32x4){bflo(w.z), bfhi(w.z), bflo(w.w), bfhi(w.w)};
                    x0 = x0 + (acc[ai][bj][m][0] * ry) * g[bj][0]; x1 = x1 + (acc[ai][bj][m][1] * ry) * g[bj][1];
                    if (out_f32) { char* op = (char*)(out_f32 + tile0) + (size_t)((ai * HALF + m * 16) * D_ + bj * HALF) * 4 + vo * 4u; *(f32x4*)op = x0; *(f32x4*)(op + 16) = x1; }
                    else { s2 += ((x0.x * x0.x + x0.y * x0.y) + (x0.z * x0.z + x0.w * x0.w)) + ((x1.x * x1.x + x1.y * x1.y) + (x1.z * x1.z + x1.w * x1.w));
                        u32x4 o; o.x = cvt_pk_bf16(x0[0], x0[1]); o.y = cvt_pk_bf16(x0[2], x0[3]); o.z = cvt_pk_bf16(x1[0], x1[1]); o.w = cvt_pk_bf16(x1[2], x1[3]);
                        *(u32x4*)(xt + (size_t)((ai * HALF + m * 16) * D_ + bj * HALF) * 2 + vo * 2u) = o; } }
                sq[ai * 4 + m] = s2; }
        if (!out_f32) { float d[2]; reduce8(sq, d);
            const int tid2 = tid_of(wr * 4 + wc); const int fr2 = tid2 & 15, fq2 = (tid2 >> 4) & 3, t2 = wc * 64 + (tid2 & 63);
            const int xoff2 = (wr * 64 + fr2 + (((fq2 & 1) << 1) | (fq2 >> 1)) * 16) * 4 + wc;
            X[xoff2] = d[0]; X[HALF * 4 + xoff2] = d[1]; LDS_WAIT(); __builtin_amdgcn_s_barrier(); asm volatile("" ::: "memory");
            if (wr == 0) { const f32x4 v = *(const LAS f32x4*)(X + t2 * 4); RS4[((size_t)u.pm * BM + t2) * 4 + u.pn] = (v.x + v.y) + (v.z + v.w); } }
        LDS_WAIT();
    }
};

template <bool F8>
__device__ __forceinline__ void mma_step(f32x4& c, const bf16x8 (&b)[2], const bf16x8 (&a)[2], int sc) {
    if constexpr (F8) {
        const i32x8 B = __builtin_shufflevector(__builtin_bit_cast(i32x4, b[0]), __builtin_bit_cast(i32x4, b[1]), 0, 1, 2, 3, 4, 5, 6, 7);
        const i32x8 A = __builtin_shufflevector(__builtin_bit_cast(i32x4, a[0]), __builtin_bit_cast(i32x4, a[1]), 0, 1, 2, 3, 4, 5, 6, 7);
        c = __builtin_amdgcn_mfma_scale_f32_16x16x128_f8f6f4(B, A, c, 0, 0, 0, 0, 0, 0); (void)sc;
    } else {
        c = __builtin_amdgcn_mfma_f32_16x16x32_bf16(b[0], a[0], c, 0, 0, 0); c = __builtin_amdgcn_mfma_f32_16x16x32_bf16(b[1], a[1], c, 0, 0, 0);
    }
}
template <bool F8, class Epi, class Sched>
__device__ __forceinline__ void gemm_phase(LAS unsigned char* lds, LAS unsigned char* xl, const Gemm g, const Sched& S, const Epi& E, const int tid) {
    const int wid = __builtin_amdgcn_readfirstlane(tid >> 6), lane = tid & 63, wr = wid >> 2, wc = wid & 3, fr = lane & 15, fq = lane >> 4;
    int sc1 = 0x7f7f7f7f; asm volatile("" : "+s"(sc1));
    int nt = g.K / BK; asm volatile("" : "+s"(nt));
    unsigned voffA[2], voffB[2]; int aoff, boff;
#define PG8_LANE_SETUP() do { const int t_ = tid_of(wid); const int fr_ = t_ & 15, fq_ = (t_ >> 4) & 3; \
        _Pragma("unroll") for (int i = 0; i < 2; ++i) { int R, C; stage_rc(t_ * 16 + i * 8192, R, C); const int Rb = (R & ~31) + perm32(R & 31); \
            voffA[i] = (unsigned)(R * g.lda + C) * 2u; voffB[i] = (unsigned)(Rb * g.ldb + C) * 2u; } \
        aoff = lds_byte(wr * 64 + fr_, fq_ * 8); boff = lds_byte(wc * 32 + fr_, fq_ * 8); } while (0)
    PG8_LANE_SETUP();
    const unsigned kstep = (unsigned)(BK * 2);
    const unsigned hstepA = (unsigned)HALF * g.lda * 2u, hstepB = (unsigned)HALF * g.ldb * 2u;
    const __amdgpu_buffer_rsrc_t srdA = __builtin_amdgcn_make_buffer_rsrc((void*)g.A, 0, 0x7fffffff, 0x00020000), srdB = __builtin_amdgcn_make_buffer_rsrc((void*)g.Bt, 0, 0x7fffffff, 0x00020000);
    const unsigned ldsw = (unsigned)wid * 1024u;
#define PG8_SA(b, h) (((b) * 2 + (h)) * HTB)
#define PG8_SB(b, h) ((4 + (b) * 2 + (h)) * HTB)
#define PG8_STAGE(bufoff, srd, goff, voff) do { _Pragma("unroll") for (int _i = 0; _i < 2; ++_i) \
        __builtin_amdgcn_raw_ptr_buffer_load_lds(srd, (LAS unsigned*)(lds + (bufoff) + ldsw + _i * 8192), 16, (voff)[_i], (goff), 0, 0); } while (0)
#define PG8_LDA(dst, b, h) do { _Pragma("unroll") for (int m = 0; m < 4; ++m) _Pragma("unroll") for (int k = 0; k < 2; ++k) dst[m][k] = *(const LAS bf16x8*)(lds + PG8_SA(b, h) + aoff + m * 2048 + k * 1024); } while (0)
#define PG8_LDB(dst, b, h) do { _Pragma("unroll") for (int n = 0; n < 2; ++n) _Pragma("unroll") for (int k = 0; k < 2; ++k) dst[n][k] = *(const LAS bf16x8*)(lds + PG8_SB(b, h) + boff + n * 2048 + k * 1024); } while (0)
#define PG8_MMA(ai, bj, At, Bt) do { __builtin_amdgcn_s_setprio(1); _Pragma("unroll") for (int m = 0; m < 4; ++m) _Pragma("unroll") for (int n = 0; n < 2; ++n) \
        mma_step<F8>(acc[ai][bj][m][n], Bt[n], At[m], sc1); __builtin_amdgcn_s_setprio(0); } while (0)
#define PG8_WAIT_V(n) asm volatile("s_waitcnt vmcnt(" #n ")" ::: "memory")
#define PG8_WAIT_L(n) asm volatile("s_waitcnt lgkmcnt(" #n ")" ::: "memory")
#define PG8_BAR __builtin_amdgcn_s_barrier()
#define PG8_SCHED __builtin_amdgcn_sched_barrier(0)
    Unit cur, nxt; int ui = 0;
    if (!S.next(0, cur)) return;
#define PG8_RSLOAD(u_, par_) do { if constexpr (Epi::RS_PREFETCH) { if (wid < 4) __builtin_amdgcn_raw_ptr_buffer_load_lds(srdR, (LAS unsigned*)(xl + (par_) * 4096 + wid * 1024), 16, \
        (unsigned)(tid_of(wid) & 63) * 16u, (unsigned)((u_).pm * BM + wid * 64) * 16u, 0, 0); } } while (0)
    __amdgpu_buffer_rsrc_t srdR; if constexpr (Epi::RS_PREFETCH) srdR = __builtin_amdgcn_make_buffer_rsrc((void*)E.rs, 0, 0x7fffffff, 0x00020000);
    PG8_RSLOAD(cur, 0);
    f32x4 acc[2][2][4][2];
#pragma unroll
    for (int a = 0; a < 2; ++a)
#pragma unroll
        for (int b = 0; b < 2; ++b)
#pragma unroll
            for (int m = 0; m < 4; ++m)
#pragma unroll
                for (int n = 0; n < 2; ++n) acc[a][b][m][n] = (f32x4){0.f, 0.f, 0.f, 0.f};
    bf16x8 At[4][2], B0[2][2], B1[2][2];
    unsigned cA = (unsigned)cur.aoff, cB = (unsigned)cur.boff;
    PG8_STAGE(PG8_SB(0, 0), srdB, cB, voffB); PG8_STAGE(PG8_SB(0, 1), srdB, cB + hstepB, voffB); PG8_STAGE(PG8_SA(0, 0), srdA, cA, voffA); PG8_STAGE(PG8_SA(0, 1), srdA, cA + hstepA, voffA);
    if (wr == 1) PG8_BAR;
    PG8_WAIT_V(2); PG8_BAR;
    PG8_STAGE(PG8_SB(1, 0), srdB, cB + kstep, voffB); PG8_STAGE(PG8_SA(1, 0), srdA, cA + kstep, voffA); PG8_STAGE(PG8_SB(1, 1), srdB, cB + hstepB + kstep, voffB);
    PG8_WAIT_V(6); PG8_BAR;
    for (;;) {
        const bool has_next = S.next(ui + 1, nxt);
        const unsigned nA = has_next ? (unsigned)nxt.aoff : cA, nB = has_next ? (unsigned)nxt.boff : cB;
        for (int t = 0; t < nt; t += 2) {
            const bool last = (t == nt - 2);
            const unsigned a1 = cA + (unsigned)(t + 1) * kstep;
            const unsigned a2 = last ? nA : cA + (unsigned)(t + 2) * kstep, b2 = last ? nB : cB + (unsigned)(t + 2) * kstep;
            const unsigned a3 = a2 + kstep, b3 = b2 + kstep;
            PG8_LDB(B0, 0, 0); PG8_LDB(B1, 0, 1); PG8_SCHED; PG8_LDA(At, 0, 0); PG8_STAGE(PG8_SA(1, 1), srdA, a1 + hstepA, voffA);
            PG8_WAIT_V(8); PG8_WAIT_L(0); PG8_BAR; PG8_MMA(0, 0, At, B0); PG8_MMA(0, 1, At, B1); PG8_BAR; PG8_SCHED;
            PG8_LDA(At, 0, 1); PG8_STAGE(PG8_SB(0, 0), srdB, b2, voffB); PG8_STAGE(PG8_SB(0, 1), srdB, b2 + hstepB, voffB); PG8_STAGE(PG8_SA(0, 0), srdA, a2, voffA);
            PG8_WAIT_V(8); PG8_WAIT_L(0); PG8_BAR; PG8_MMA(1, 0, At, B0); PG8_MMA(1, 1, At, B1); PG8_BAR; PG8_SCHED;
            PG8_LDB(B0, 1, 0); PG8_LDB(B1, 1, 1); PG8_SCHED; PG8_LDA(At, 1, 0); PG8_STAGE(PG8_SA(0, 1), srdA, a2 + hstepA, voffA);
            PG8_WAIT_V(8); PG8_WAIT_L(0); PG8_BAR; PG8_MMA(0, 0, At, B0); PG8_MMA(0, 1, At, B1); PG8_BAR; PG8_SCHED;
            PG8_LDA(At, 1, 1); PG8_STAGE(PG8_SB(1, 0), srdB, b3, voffB); PG8_STAGE(PG8_SB(1, 1), srdB, b3 + hstepB, voffB); PG8_STAGE(PG8_SA(1, 0), srdA, a3, voffA);
            PG8_WAIT_V(8); PG8_WAIT_L(0); PG8_BAR; PG8_MMA(1, 0, At, B0); PG8_MMA(1, 1, At, B1); PG8_BAR; PG8_SCHED;
        }
        if (wr == 0) PG8_BAR;
        E(acc, cur, wr, wc, fr, fq, Epi::RS_PREFETCH ? xl + (ui & 1) * 4096 : xl);
        if (!has_next) break;
#pragma unroll
        for (int a = 0; a < 2; ++a)
#pragma unroll
            for (int b = 0; b < 2; ++b)
#pragma unroll
                for (int m = 0; m < 4; ++m)
#pragma unroll
                    for (int n = 0; n < 2; ++n) acc[a][b][m][n] = (f32x4){0.f, 0.f, 0.f, 0.f};
        cur = nxt; cA = nA; cB = nB; ++ui;
        PG8_RSLOAD(cur, ui & 1);
        PG8_LANE_SETUP();
        if (wr == 1) PG8_BAR;
    }
    PG8_WAIT_V(0);
    PG8_BAR;
#undef PG8_LANE_SETUP
#undef PG8_RSLOAD
#undef PG8_SA
#undef PG8_SB
#undef PG8_STAGE
#undef PG8_LDA
#undef PG8_LDB
#undef PG8_MMA
#undef PG8_WAIT_V
#undef PG8_WAIT_L
#undef PG8_BAR
#undef PG8_SCHED
}
}

struct Args { const float* in[30]; float* out; unsigned char* ws; int ph_lo, ph_hi; };
enum { I_X = 0, I_MEM, I_RELB, I_LN_MIX_PRE, I_LN_MIX_POST, I_W_IN, I_PE_K, I_PE_V, I_CW_K, I_CW_V, I_CONV_W, I_CONV_B, I_LRU_WA, I_LRU_BA, I_LRU_WX, I_LRU_BX, I_LRU_LAM,
       I_GN_ATTN, I_GN_LRU, I_W_OUT, I_LN_X_PRE, I_LN_X_POST, I_LN_MEM, I_XQ, I_XKV, I_XO, I_LN_MLP_PRE, I_LN_MLP_POST, I_W1, I_W2 };

__device__ __forceinline__ void tr_item(const float* W, long ldw, bool kperm, bf16_t* WT, long ldt, int k0, int n0, int srccol, float nscale, const float* gain, LAS float* scr, int lane, bool f8 = false) {
    const int kr = lane >> 4, nq = lane & 15;
#pragma unroll 8
    for (int i = 0; i < 16; ++i) { const int kk = 4 * i + kr; const int k = k0 + kk; const long srow = kperm ? (long)((k & 63) * 64 + (k >> 6)) : (long)k;
        f32x4 v = {0.f, 0.f, 0.f, 0.f}; if (srccol >= 0) v = *(const f32x4*)(W + srow * ldw + srccol); float gs = nscale; if (gain) gs *= gain[k]; v *= gs;
        LAS float* d = scr + kk * 65 + 4 * nq; d[0] = v.x; d[1] = v.y; d[2] = v.z; d[3] = v.w; }
    LDS_WAIT(); asm volatile("" ::: "memory");
    const int c = lane & 7;
#pragma unroll
    for (int j = 0; j < 8; ++j) { const int n = (lane >> 3) + 8 * j; const LAS float* sp = scr + (8 * c) * 65 + n;
        if (f8) { int p0 = __builtin_amdgcn_cvt_pk_fp8_f32(sp[0 * 65], sp[1 * 65], 0, false); p0 = __builtin_amdgcn_cvt_pk_fp8_f32(sp[2 * 65], sp[3 * 65], p0, true);
            int p1 = __builtin_amdgcn_cvt_pk_fp8_f32(sp[4 * 65], sp[5 * 65], 0, false); p1 = __builtin_amdgcn_cvt_pk_fp8_f32(sp[6 * 65], sp[7 * 65], p1, true);
            *(u32x2*)((unsigned char*)WT + (size_t)(n0 + n) * ldt + k0 + 8 * c) = (u32x2){(unsigned)p0, (unsigned)p1}; continue; }
        u32x4 o; o.x = pk2(sp[0 * 65], sp[1 * 65]); o.y = pk2(sp[2 * 65], sp[3 * 65]); o.z = pk2(sp[4 * 65], sp[5 * 65]); o.w = pk2(sp[6 * 65], sp[7 * 65]);
        *(u32x4*)(WT + (size_t)(n0 + n) * ldt + k0 + 8 * c) = o; }
    LDS_WAIT(); asm volatile("" ::: "memory");
}
__device__ __forceinline__ int wina_srccol(int n) {
    if (n < 512) return n;
    if (n < 640) return n;
    if (n < 768) return 768 + (n - 640);
    if (n < 896) return 1024 + (n - 768);
    if (n < 920) return 1280 + (n - 896);
    if (n < 1024) return -1;
    if (n < 1536) return 1304 + (n - 1024);
    return 1816 + (n - 1536);
}
__device__ __forceinline__ int winv_srccol(int n) {
    if (n < 128) return 640 + n;
    if (n < 256) return 896 + (n - 128);
    if (n < 384) return 1152 + (n - 256);
    return -1;
}
__device__ __forceinline__ void norm_row_to_bf16(const float* xrow, bf16_t* orow, int lane) {
    const f32x4* xr = (const f32x4*)xrow + lane; f32x4 v[4]; float s = 0.f;
#pragma unroll
    for (int j = 0; j < 4; ++j) { v[j] = xr[64 * j]; s += (v[j].x * v[j].x + v[j].y * v[j].y) + (v[j].z * v[j].z + v[j].w * v[j].w); }
    const float r = 1.0f / sqrtf(wave_sum(s) * (1.f / D_) + EPS_);
    u32x2* o8 = (u32x2*)orow + lane;
#pragma unroll
    for (int j = 0; j < 4; ++j) { u32x2 w; w.x = pk2(v[j].x * r, v[j].y * r); w.y = pk2(v[j].z * r, v[j].w * r); o8[64 * j] = w; }
}
__device__ __forceinline__ void prologue_phase(const Args& A, LAS unsigned char* lds, int tid, int wave, int lane) {
    LAS float* scr = (LAS float*)(lds + wave * 17408);
    const int gw = blockIdx.x * 8 + wave, NGW = gridDim.x * 8;
    constexpr int C0 = 512, C1 = C0 + 128, C2 = C1 + 256, C3 = C2 + 256, C4 = C3 + 256, C5 = C4 + 256, C6 = C5 + 256, C7 = C6 + 1024, C8 = C7 + 1024, C9 = C8 + 64, C10 = C9 + 64, C11 = C10 + 8, C12 = C11 + 8;
    for (int it = gw; it < NL_ * C12; it += NGW) {
        const int l = it / C12; int r = it % C12;
        unsigned char* wl = A.ws + WS_W + (size_t)l * WL_STRIDE;
        const int nl = 4 * (lane & 15);
        if (r < C0) { const int kb = r / 32, nb = r % 32; const int n = nb * 64 + nl;
            tr_item(A.in[I_W_IN] + (size_t)l * D_ * INC_, INC_, false, (bf16_t*)(wl + W_INA), D_, kb * 64, nb * 64, wina_srccol(n), n < 512 ? C2_ : 1.0f, A.in[I_LN_MIX_PRE] + l * D_, scr, lane); continue; }
        if (r < C1) { r -= C0; const int kb = r / 8, nb = r % 8; const int n = nb * 64 + nl;
            tr_item(A.in[I_W_IN] + (size_t)l * D_ * INC_, INC_, false, (bf16_t*)(wl + W_INV), D_, kb * 64, nb * 64, winv_srccol(n), 1.0f, A.in[I_LN_MIX_PRE] + l * D_, scr, lane); continue; }
        if (r < C2) { r -= C1; const int kb = r / 16, nb = r % 16;
            const float* gain = (kb < 8) ? A.in[I_GN_ATTN] + l * 512 : A.in[I_GN_LRU] + l * 512 - 512;
            tr_item(A.in[I_W_OUT] + (size_t)l * D_ * D_, D_, false, (bf16_t*)(wl + W_OUT), D_, kb * 64, nb * 64, nb * 64 + nl, 1.0f, gain, scr, lane); continue; }
        if (r < C3) { r -= C2; const int kb = r / 16, nb = r % 16;
            tr_item(A.in[I_XQ] + (size_t)l * D_ * D_, D_, false, (bf16_t*)(wl + W_XQ), D_, kb * 64, nb * 64, nb * 64 + nl, XC2_, A.in[I_LN_X_PRE] + l * D_, scr, lane); continue; }
        if (r < C4) { r -= C3; const int kb = r / 16, nb = r % 16;
            tr_item(A.in[I_XKV] + (size_t)l * D_ * 2 * D_, 2 * D_, false, (bf16_t*)(wl + W_XK), D_, kb * 64, nb * 64, nb * 64 + nl, 1.0f, A.in[I_LN_MEM] + l * D_, scr, lane); continue; }
        if (r < C5) { r -= C4; const int kb = r / 16, nb = r % 16;
            tr_item(A.in[I_XKV] + (size_t)l * D_ * 2 * D_, 2 * D_, false, (bf16_t*)(wl + W_XV), D_, kb * 64, nb * 64, 1024 + nb * 64 + nl, 1.0f, A.in[I_LN_MEM] + l * D_, scr, lane); continue; }
        if (r < C6) { r -= C5; const int kb = r / 16, nb = r % 16;
            tr_item(A.in[I_XO] + (size_t)l * D_ * D_, D_, false, (bf16_t*)(wl + W_XO), D_, kb * 64, nb * 64, nb * 64 + nl, 1.0f, nullptr, scr, lane); continue; }
        if (r < C7) { r -= C6; const int kb = r / 64, nb = r % 64;
            tr_item(A.in[I_W1] + (size_t)l * D_ * FF_, FF_, false, (bf16_t*)(wl + W_1), D_, kb * 64, nb * 64, nb * 64 + nl, 1.0f, A.in[I_LN_MLP_PRE] + l * D_, scr, lane); continue; }
        if (r < C8) { r -= C7; const int kb = r / 16, nb = r % 16;
            tr_item(A.in[I_W2] + (size_t)l * FF_ * D_, D_, false, (bf16_t*)(wl + W_2), FF_, kb * 64, nb * 64, nb * 64 + nl, W8_SCALE, nullptr, scr, lane, true); continue; }
        if (r < C10) { r -= C8; const int isv = r >> 6; r &= 63;
            const float* W = A.in[isv ? I_CW_V : I_CW_K] + (size_t)l * 4096 * 64; bf16_t* WF = (bf16_t*)(wl + (isv ? W_CV : W_CK)); const float* pe = A.in[isv ? I_PE_V : I_PE_K] + l * 4096;
            const int kr = lane >> 4, nq = lane & 15; f32x4 pacc = {0.f, 0.f, 0.f, 0.f};
#pragma unroll 8
            for (int i = 0; i < 16; ++i) { const int kk = 4 * i + kr; const int srck = isv ? (kk * 64 + r) : (r * 64 + kk);
                const f32x4 v = *(const f32x4*)(W + (size_t)srck * 64 + 4 * nq); pacc += v * pe[srck];
                LAS float* d = scr + kk * 65 + 4 * nq; d[0] = v.x; d[1] = v.y; d[2] = v.z; d[3] = v.w; }
#pragma unroll
            for (int cc = 0; cc < 4; ++cc) { pacc[cc] += shx(pacc[cc], 16); pacc[cc] += shx(pacc[cc], 32); }
            if (lane < 16) *(f32x4*)((float*)(A.ws + WS_PEP) + (size_t)((l * 2 + isv) * 64 + r) * 64 + 4 * nq) = pacc;
            LDS_WAIT(); asm volatile("" ::: "memory");
            const int r32 = lane & 31, hi = lane >> 5;
#pragma unroll
            for (int c8 = 0; c8 < 8; ++c8) { const int ksl = c8 >> 1, half = c8 & 1; const LAS float* sp = scr + (ksl * 16 + 8 * hi) * 65 + half * 32 + r32;
                u32x4 w; w.x = pk2(sp[0 * 65], sp[1 * 65]); w.y = pk2(sp[2 * 65], sp[3 * 65]); w.z = pk2(sp[4 * 65], sp[5 * 65]); w.w = pk2(sp[6 * 65], sp[7 * 65]);
                *(u32x4*)(WF + ((size_t)((r * 4 + ksl) * 2 + half) * 64 + lane) * 8) = w; }
            LDS_WAIT(); asm volatile("" ::: "memory");
            continue; }
        if (r < C11) { r -= C10;
            tr_item(A.in[I_LRU_WA] + (size_t)(l * 8 + r) * 4096, 64, false, (bf16_t*)(wl + W_A) + r * 4096, 64, 0, 0, nl, 1.0f, nullptr, scr, lane); continue; }
        { r -= C11;
            tr_item(A.in[I_LRU_WX] + (size_t)(l * 8 + r) * 4096, 64, false, (bf16_t*)(wl + W_X) + r * 4096, 64, 0, 0, nl, 1.0f, nullptr, scr, lane); }
    }
    for (int m = gw; m < T_; m += NGW) {
        const f32x4* xr = (const f32x4*)(A.in[I_X] + (size_t)m * D_) + lane; f32x4 v[4]; float sq = 0.f;
#pragma unroll
        for (int j = 0; j < 4; ++j) { v[j] = xr[64 * j]; sq += (v[j].x * v[j].x + v[j].y * v[j].y) + (v[j].z * v[j].z + v[j].w * v[j].w); }
        sq = wave_sum(sq); if (lane == 0) ((f32x4*)(A.ws + WS_RS))[m] = (f32x4){sq, 0.f, 0.f, 0.f};
        u32x2* o8 = (u32x2*)((bf16_t*)(A.ws + WS_HB) + (size_t)m * D_) + lane;
#pragma unroll
        for (int j = 0; j < 4; ++j) { u32x2 w; w.x = pk2(v[j].x, v[j].y); w.y = pk2(v[j].z, v[j].w); o8[64 * j] = w; } }
    for (int m = gw; m < NB_ * MEM_; m += NGW) norm_row_to_bf16(A.in[I_MEM] + (size_t)m * D_, (bf16_t*)(A.ws + WS_MNB) + (size_t)m * D_, lane);
    { unsigned z = 0u; asm volatile("" : "+v"(z));
      for (int i = blockIdx.x * NTHREADS + tid; i < 128 * 4 * 256; i += gridDim.x * NTHREADS) ((u32x2*)(A.ws + WS_SLOT))[i] = (u32x2){z, z};
      for (int i = blockIdx.x * NTHREADS + tid; i < NL_ * 512 * 512; i += gridDim.x * NTHREADS) ((u32x2*)(A.ws + WS_AGG2))[i] = (u32x2){z, z}; }
}

__device__ __forceinline__ void compress_item(const Args& A, int l, int item, LAS unsigned char* lds, int wave) {
    const int tid = tid_of(wave); const int lane = tid & 63;
    const int which = item >> 6, rt = (item >> 1) & 31, half = item & 1;
    const int r32 = lane & 31, hi = lane >> 5;
    const int row = rt * 32 + r32;
    const int g = row >> 9, b = (row >> 7) & 3, n = row & 127;
    const bf16_t* Wf = (const bf16_t*)(A.ws + WS_W + (size_t)l * WL_STRIDE + (which ? W_CV : W_CK)) + ((size_t)((wave * 32) * 2 + half) * 64 + lane) * 8;
    const bf16_t* Ak = (const bf16_t*)(A.ws + WS_KP) + ((size_t)g * T_ + (size_t)b * S_ + n * 64) * 64 + wave * 512 + 8 * hi;
    const bf16_t* Av = (const bf16_t*)(A.ws + WS_VT) + (size_t)(g * 64 + wave * 8) * T_ + (size_t)b * S_ + n * 64 + 8 * hi;
    float bp = 0.f;
    { const float* pp = (const float*)(A.ws + WS_PEP) + (size_t)((l * 2 + which) * 64 + wave * 8) * 64 + lane;
#pragma unroll
      for (int i = 0; i < 8; ++i) bp += pp[i * 64]; }
    f32x16 c0 = {};
#pragma unroll 8
    for (int ks = 0; ks < 32; ++ks) {
        const bf16x8 af = which ? *(const bf16x8*)(Av + (size_t)(ks >> 2) * T_ + (ks & 3) * 16) : *(const bf16x8*)(Ak + ks * 16);
        const bf16x8 b0 = *(const bf16x8*)(Wf + ks * 1024);
        c0 = __builtin_amdgcn_mfma_f32_32x32x16_bf16(af, b0, c0, 0, 0, 0); }
    LAS float* red = (LAS float*)lds + wave * 1024;
#pragma unroll
    for (int r = 0; r < 16; ++r) red[crow(r, hi) * 32 + r32] = c0[r];
    ((LAS float*)lds)[8 * 1024 + tid] = bp;
    __syncthreads();
    { const int orow = rt * 32 + (tid >> 4), e0 = half * 32 + (tid & 15) * 2;
      float s0 = 0.f, s1 = 0.f;
#pragma unroll
      for (int w = 0; w < 8; ++w) { s0 += ((LAS float*)lds)[8 * 1024 + w * 64 + e0]; s1 += ((LAS float*)lds)[8 * 1024 + w * 64 + e0 + 1]; }
#pragma unroll
      for (int w = 0; w < 8; ++w) { const f32x2 v = *(const LAS f32x2*)((LAS float*)lds + w * 1024 + tid * 2); s0 += v.x; s1 += v.y; }
      if (which == 0) *(unsigned*)((bf16_t*)(A.ws + WS_KCB) + (size_t)orow * 64 + e0) = pk2(s0, s1);
      else { bf16_t* vct = (bf16_t*)(A.ws + WS_VCT) + (size_t)(orow >> 7) * 8192 + (orow & 127); vct[(e0 + 0) * 128] = (bf16_t)f2bf(s0); vct[(e0 + 1) * 128] = (bf16_t)f2bf(s1); } }
    __syncthreads();
}

constexpr int LRU_WREG = 17408;
constexpr int LRU_XSS = 8 * LRU_WREG, LRU_CARRY = LRU_XSS + 2048;
__device__ __forceinline__ float one_minus_exp(float x) {
    float p = 1.0f + x * (1.0f / 6.0f); p = 1.0f + x * 0.2f * p; p = 1.0f + x * 0.25f * p; p = 1.0f + x * (1.0f / 3.0f) * p; p = 1.0f + x * 0.5f * p; return -x * p;
}
template <int PASS>
__device__ __forceinline__ void lru_item(const Args& A, int l, int b, int chunk, LAS unsigned char* lds, int wave) {
    const int tid = tid_of(wave); const int lane = tid & 63;
    const int n = wave, r32 = lane & 31, hi = lane >> 5;
    const size_t R0 = (size_t)b * S_ + (size_t)chunk * 64; const int t0 = chunk * 64;
    const bf16_t* XR = (const bf16_t*)(A.ws + WS_XR);
    float* AGG = (float*)(A.ws + WS_AGG);
    LAS unsigned char* wreg = lds + wave * LRU_WREG;
    u32x4 tv[9]; float wv[5];
    { const int c8 = lane & 7;
#pragma unroll
      for (int i = 0; i < 9; ++i) { const int rr = (lane >> 3) + 8 * i; const int tt = t0 + rr - 3; const bool ok = (rr < 67) && (tt >= 0);
          const long dr = ok ? (long)(rr - 3) : 0; const u32x4 v = *(const u32x4*)(XR + (R0 + dr) * 512 + n * 64 + c8 * 8); tv[i] = ok ? v : (u32x4){0u, 0u, 0u, 0u}; }
#pragma unroll
      for (int j = 0; j < 4; ++j) wv[j] = A.in[I_CONV_W][l * 2048 + j * 512 + n * 64 + lane];
      wv[4] = A.in[I_CONV_B][l * 512 + n * 64 + lane]; }
    if (PASS == 2) {
        const float* ag = AGG + (size_t)(b * 128) * 1024 + tid; float H = 0.f; int c = 0;
        for (; c + 16 <= chunk; c += 16) { float a_[16], b_[16];
#pragma unroll
            for (int q = 0; q < 16; ++q) { a_[q] = ag[(size_t)(c + q) * 1024]; b_[q] = ag[(size_t)(c + q) * 1024 + 512]; }
#pragma unroll
            for (int q = 0; q < 16; ++q) H = a_[q] * H + b_[q]; }
        for (; c < chunk; ++c) H = ag[(size_t)c * 1024] * H + ag[(size_t)c * 1024 + 512];
        ((LAS float*)(lds + LRU_CARRY))[tid] = H;
    }
    { const int c8 = lane & 7;
#pragma unroll
      for (int i = 0; i < 9; ++i) { const int rr = (lane >> 3) + 8 * i; if (rr < 67) *(LAS u32x4*)(wreg + rr * 144 + c8 * 16) = tv[i]; }
      LAS float* wl_ = (LAS float*)(wreg + 9728);
#pragma unroll
      for (int j = 0; j < 5; ++j) wl_[j * 64 + lane] = wv[j]; }
    LDS_WAIT(); asm volatile("" ::: "memory");
    bf16x8 xa[2][4];
    { const LAS float* wl_ = (const LAS float*)(wreg + 9728);
#pragma unroll
      for (int ks = 0; ks < 4; ++ks) { const int cl0 = 16 * ks + 8 * hi;
          f32x4 w0[4], w1[4];
#pragma unroll
          for (int j = 0; j < 4; ++j) { w0[j] = *(const LAS f32x4*)(wl_ + j * 64 + cl0); w1[j] = *(const LAS f32x4*)(wl_ + j * 64 + cl0 + 4); }
          const f32x4 b0 = *(const LAS f32x4*)(wl_ + 256 + cl0), b1 = *(const LAS f32x4*)(wl_ + 256 + cl0 + 4);
#pragma unroll
          for (int mt = 0; mt < 2; ++mt) { f32x4 a0 = b0, a1 = b1;
#pragma unroll
              for (int j = 0; j < 4; ++j) { const u32x4 v = *(const LAS u32x4*)(wreg + (32 * mt + r32 + j) * 144 + cl0 * 2);
                  a0 += w0[j] * (f32x4){bflo(v.x), bfhi(v.x), bflo(v.y), bfhi(v.y)}; a1 += w1[j] * (f32x4){bflo(v.z), bfhi(v.z), bflo(v.w), bfhi(v.w)}; }
              u32x4 pw; pw.x = pk2(a0.x, a0.y); pw.y = pk2(a0.z, a0.w); pw.z = pk2(a1.x, a1.y); pw.w = pk2(a1.z, a1.w);
              xa[mt][ks] = __builtin_bit_cast(bf16x8, pw); } } }
    if (PASS == 2) __syncthreads();
    else { LDS_WAIT(); asm volatile("" ::: "memory"); }
    const bf16_t* Wa = (const bf16_t*)(A.ws + WS_W + (size_t)l * WL_STRIDE + W_A) + n * 4096;
    const bf16_t* Wx = (const bf16_t*)(A.ws + WS_W + (size_t)l * WL_STRIDE + W_X) + n * 4096;
    LAS float* stage = (LAS float*)wreg;
#pragma unroll 1
    for (int nt = 0; nt < 2; ++nt) {
        const int e = 32 * nt + r32, ch = n * 64 + e;
        f32x16 Rr[2] = {}, Ii[2] = {}, Xc[2] = {};
#pragma unroll
        for (int ks = 0; ks < 4; ++ks) {
            const bf16x8 wa = *(const bf16x8*)(Wa + e * 64 + 16 * ks + 8 * hi), wx = *(const bf16x8*)(Wx + e * 64 + 16 * ks + 8 * hi);
            bf16x8 idf;
#pragma unroll
            for (int j = 0; j < 8; ++j) idf[j] = (16 * ks + 8 * hi + j == e) ? (short)0x3F80 : (short)0;
#pragma unroll
            for (int mt = 0; mt < 2; ++mt) {
                Rr[mt] = __builtin_amdgcn_mfma_f32_32x32x16_bf16(xa[mt][ks], wa, Rr[mt], 0, 0, 0);
                Ii[mt] = __builtin_amdgcn_mfma_f32_32x32x16_bf16(xa[mt][ks], wx, Ii[mt], 0, 0, 0);
                Xc[mt] = __builtin_amdgcn_mfma_f32_32x32x16_bf16(xa[mt][ks], idf, Xc[mt], 0, 0, 0); } }
        const float nba = -LOG2E_ * A.in[I_LRU_BA][l * 512 + ch], nbx = -LOG2E_ * A.in[I_LRU_BX][l * 512 + ch], lam = A.in[I_LRU_LAM][l * 512 + ch];
        const float cl2 = -8.0f * log1pf(expf(-lam)) * LOG2E_;
#pragma unroll
        for (int mt = 0; mt < 2; ++mt)
#pragma unroll
            for (int r = 0; r < 16; ++r) { const float rg = rcp(1.0f + ex2(__builtin_fmaf(Rr[mt][r], -LOG2E_, nba))), ig = rcp(1.0f + ex2(__builtin_fmaf(Ii[mt][r], -LOG2E_, nbx))); const float av = ex2(cl2 * rg);
                Rr[mt][r] = av; Ii[mt][r] = __builtin_amdgcn_sqrtf(__builtin_fmaf(-av, av, 1.0f)) * (ig * Xc[mt][r]); }
        float GA[8], GB[8];
#pragma unroll
        for (int gi = 0; gi < 8; ++gi) { const int mt = gi >> 2, i = gi & 3; float a = 1.f, bq = 0.f;
#pragma unroll
            for (int j = 0; j < 4; ++j) { const float aa = Rr[mt][4 * i + j]; bq = aa * bq + Ii[mt][4 * i + j]; a *= aa; }
            GA[gi] = a; GB[gi] = bq; }
        float H = 0.f;
        if (PASS == 2) H = ((const LAS float*)(lds + LRU_CARRY))[ch];
        float Hin[8]; float Atot = 1.f;
#pragma unroll
        for (int gi = 0; gi < 8; ++gi) {
            const auto ra = __builtin_amdgcn_permlane32_swap(__float_as_uint(GA[gi]), __float_as_uint(GA[gi]), false, false); const auto rb = __builtin_amdgcn_permlane32_swap(__float_as_uint(GB[gi]), __float_as_uint(GB[gi]), false, false);
            const float A0 = __uint_as_float(ra[0]), A1 = __uint_as_float(ra[1]), B0 = __uint_as_float(rb[0]), B1 = __uint_as_float(rb[1]);
            const float h0 = H; H = A0 * H + B0; const float h1 = H; H = A1 * H + B1; Hin[gi] = hi ? h1 : h0; Atot *= A0 * A1; }
        if (PASS == 1) { if (hi == 0) { float* ag = AGG + (size_t)(b * 128 + chunk) * 1024 + ch; ag[0] = Atot; ag[512] = H; } }
        else {
#pragma unroll
            for (int gi = 0; gi < 8; ++gi) { const int mt = gi >> 2, i = gi & 3; float h = Hin[gi];
#pragma unroll
                for (int j = 0; j < 4; ++j) { h = Rr[mt][4 * i + j] * h + Ii[mt][4 * i + j]; stage[(32 * mt + 8 * i + 4 * hi + j) * 68 + e] = h; } }
        }
    }
    if (PASS == 2) {
        LDS_WAIT(); asm volatile("" ::: "memory");
        const bf16_t* YG = (const bf16_t*)(A.ws + WS_YG); bf16_t* AB = (bf16_t*)(A.ws + WS_AB);
        LAS float* xss = (LAS float*)(lds + LRU_XSS);
        f32x4 v[8][2];
#pragma unroll
        for (int it = 0; it < 8; ++it) { const int row = it * 8 + (lane >> 3), c8 = lane & 7;
            if ((it & 1) == 0) asm volatile("" ::: "memory");
            const f32x4 h0 = *(const LAS f32x4*)(stage + row * 68 + c8 * 8), h1 = *(const LAS f32x4*)(stage + row * 68 + c8 * 8 + 4);
            const u32x4 y = *(const u32x4*)(YG + (R0 + row) * 512 + n * 64 + c8 * 8);
            v[it][0] = h0 * (f32x4){bflo(y.x), bfhi(y.x), bflo(y.y), bfhi(y.y)}; v[it][1] = h1 * (f32x4){bflo(y.z), bfhi(y.z), bflo(y.w), bfhi(y.w)};
            float ss = (v[it][0].x * v[it][0].x + v[it][0].y * v[it][0].y) + (v[it][0].z * v[it][0].z + v[it][0].w * v[it][0].w)
                     + (v[it][1].x * v[it][1].x + v[it][1].y * v[it][1].y) + (v[it][1].z * v[it][1].z + v[it][1].w * v[it][1].w);
            ss += __uint_as_float(__builtin_amdgcn_update_dpp(0u, __float_as_uint(ss), 0xB1, 0xF, 0xF, false)); ss += __uint_as_float(__builtin_amdgcn_update_dpp(0u, __float_as_uint(ss), 0x4E, 0xF, 0xF, false)); ss += __uint_as_float(__builtin_amdgcn_update_dpp(0u, __float_as_uint(ss), 0x141, 0xF, 0xF, false));
            if (c8 == 0) xss[wave * 64 + row] = ss; }
        __syncthreads();
#pragma unroll
        for (int it = 0; it < 8; ++it) { const int row = it * 8 + (lane >> 3), c8 = lane & 7; float tot = 0.f;
#pragma unroll
            for (int w = 0; w < 8; ++w) tot += xss[w * 64 + row];
            const float ri = 1.0f / sqrtf(tot * (1.f / 512.f) + EPS_);
            const f32x4 a = v[it][0] * ri, c = v[it][1] * ri;
            u32x4 o; o.x = pk2(a.x, a.y); o.y = pk2(a.z, a.w); o.z = pk2(c.x, c.y); o.w = pk2(c.z, c.w);
            *(u32x4*)(AB + (R0 + row) * 1024 + 512 + n * 64 + c8 * 8) = o; }
        __syncthreads();
    }
}


constexpr size_t WS_FLG = 32768;
__device__ __forceinline__ void lru_item_1p(const Args& A, int l, int b, int chunk, LAS unsigned char* lds, int wave) {
    const int tid = tid_of(wave); const int lane = tid & 63;
    const int n = wave, r32 = lane & 31, hi = lane >> 5;
    const size_t R0 = (size_t)b * S_ + (size_t)chunk * 64; const int t0 = chunk * 64;
    const bf16_t* XR = (const bf16_t*)(A.ws + WS_XR);
    unsigned long long* AGG2 = (unsigned long long*)(A.ws + WS_AGG2) + (size_t)(l * 512 + b * 128) * 512;
    LAS unsigned char* wreg = lds + wave * LRU_WREG;
    u32x4 tv[9]; float wv[5];
    const bf16_t* Wa = (const bf16_t*)(A.ws + WS_W + (size_t)l * WL_STRIDE + W_A) + n * 4096;
    const bf16_t* Wx = (const bf16_t*)(A.ws + WS_W + (size_t)l * WL_STRIDE + W_X) + n * 4096;
    float nbav[2], nbxv[2], lamv[2];
    { const int c8 = lane & 7;
#pragma unroll
      for (int i = 0; i < 9; ++i) { const int rr = (lane >> 3) + 8 * i; const int tt = t0 + rr - 3; const bool ok = (rr < 67) && (tt >= 0);
          const long dr = ok ? (long)(rr - 3) : 0; const u32x4 v = *(const u32x4*)(XR + (R0 + dr) * 512 + n * 64 + c8 * 8); tv[i] = ok ? v : (u32x4){0u, 0u, 0u, 0u}; }
#pragma unroll
      for (int j = 0; j < 4; ++j) wv[j] = A.in[I_CONV_W][l * 2048 + j * 512 + n * 64 + lane];
      wv[4] = A.in[I_CONV_B][l * 512 + n * 64 + lane];
#pragma unroll
      for (int nt = 0; nt < 2; ++nt) { const int e = 32 * nt + r32, ch = n * 64 + e;
          nbav[nt] = A.in[I_LRU_BA][l * 512 + ch]; nbxv[nt] = A.in[I_LRU_BX][l * 512 + ch]; lamv[nt] = A.in[I_LRU_LAM][l * 512 + ch]; } }
    { const int c8 = lane & 7;
#pragma unroll
      for (int i = 0; i < 9; ++i) { const int rr = (lane >> 3) + 8 * i; if (rr < 67) *(LAS u32x4*)(wreg + rr * 144 + c8 * 16) = tv[i]; }
      LAS float* wl_ = (LAS float*)(wreg + 9728);
#pragma unroll
      for (int j = 0; j < 5; ++j) wl_[j * 64 + lane] = wv[j]; }
    LDS_WAIT(); asm volatile("" ::: "memory");
    bf16x8 xa[2][4];
    { const LAS float* wl_ = (const LAS float*)(wreg + 9728);
#pragma unroll
      for (int ks = 0; ks < 4; ++ks) { const int cl0 = 16 * ks + 8 * hi;
          f32x4 w0[4], w1[4];
#pragma unroll
          for (int j = 0; j < 4; ++j) { w0[j] = *(const LAS f32x4*)(wl_ + j * 64 + cl0); w1[j] = *(const LAS f32x4*)(wl_ + j * 64 + cl0 + 4); }
          const f32x4 b0 = *(const LAS f32x4*)(wl_ + 256 + cl0), b1 = *(const LAS f32x4*)(wl_ + 256 + cl0 + 4);
#pragma unroll
          for (int mt = 0; mt < 2; ++mt) { f32x4 a0 = b0, a1 = b1;
#pragma unroll
              for (int j = 0; j < 4; ++j) { const u32x4 v = *(const LAS u32x4*)(wreg + (32 * mt + r32 + j) * 144 + cl0 * 2);
                  a0 += w0[j] * (f32x4){bflo(v.x), bfhi(v.x), bflo(v.y), bfhi(v.y)}; a1 += w1[j] * (f32x4){bflo(v.z), bfhi(v.z), bflo(v.w), bfhi(v.w)}; }
              u32x4 pw; pw.x = pk2(a0.x, a0.y); pw.y = pk2(a0.z, a0.w); pw.z = pk2(a1.x, a1.y); pw.w = pk2(a1.z, a1.w);
              xa[mt][ks] = __builtin_bit_cast(bf16x8, pw); } } }
    f32x16 Av[2][2], Bv[2][2];
#pragma unroll
    for (int nt = 0; nt < 2; ++nt) {
        const int e = 32 * nt + r32, ch = n * 64 + e;
        f32x16 Rr[2] = {}, Ii[2] = {}, Xc[2] = {};
#pragma unroll
        for (int ks = 0; ks < 4; ++ks) {
            const bf16x8 wa = *(const bf16x8*)(Wa + e * 64 + 16 * ks + 8 * hi), wx = *(const bf16x8*)(Wx + e * 64 + 16 * ks + 8 * hi);
            bf16x8 idf;
#pragma unroll
            for (int j = 0; j < 8; ++j) idf[j] = (16 * ks + 8 * hi + j == e) ? (short)0x3F80 : (short)0;
#pragma unroll
            for (int mt = 0; mt < 2; ++mt) {
                Rr[mt] = __builtin_amdgcn_mfma_f32_32x32x16_bf16(xa[mt][ks], wa, Rr[mt], 0, 0, 0);
                Ii[mt] = __builtin_amdgcn_mfma_f32_32x32x16_bf16(xa[mt][ks], wx, Ii[mt], 0, 0, 0);
                Xc[mt] = __builtin_amdgcn_mfma_f32_32x32x16_bf16(xa[mt][ks], idf, Xc[mt], 0, 0, 0); } }
        const float nba = -LOG2E_ * nbav[nt], nbx = -LOG2E_ * nbxv[nt], lam = lamv[nt];
        const float xl_ = ex2(-LOG2E_ * lam);
        const float cl2 = -8.0f * LOG2E_ * (xl_ < 0.03f ? xl_ * (1.0f - xl_ * (0.5f - xl_ * (0.33333334f - xl_ * 0.25f))) : __builtin_amdgcn_logf(1.0f + xl_) * 0.69314718f);
#pragma unroll
        for (int mt = 0; mt < 2; ++mt)
#pragma unroll
            for (int r = 0; r < 16; ++r) { const float rg = rcp(1.0f + ex2(__builtin_fmaf(Rr[mt][r], -LOG2E_, nba))), ig = rcp(1.0f + ex2(__builtin_fmaf(Ii[mt][r], -LOG2E_, nbx))); const float av = ex2(cl2 * rg);
                Av[nt][mt][r] = av; Bv[nt][mt][r] = __builtin_amdgcn_sqrtf(__builtin_fmaf(-av, av, 1.0f)) * (ig * Xc[mt][r]); }
        float H = 0.f, Atot = 1.f;
#pragma unroll
        for (int gi = 0; gi < 8; ++gi) { const int mt = gi >> 2, i = gi & 3; float a = 1.f, bq = 0.f;
#pragma unroll
            for (int j = 0; j < 4; ++j) { const float aa = Av[nt][mt][4 * i + j]; bq = aa * bq + Bv[nt][mt][4 * i + j]; a *= aa; }
            const auto ra = __builtin_amdgcn_permlane32_swap(__float_as_uint(a), __float_as_uint(a), false, false); const auto rb = __builtin_amdgcn_permlane32_swap(__float_as_uint(bq), __float_as_uint(bq), false, false);
            const float A0 = __uint_as_float(ra[0]), A1 = __uint_as_float(ra[1]), B0 = __uint_as_float(rb[0]), B1 = __uint_as_float(rb[1]);
            H = A0 * H + B0; H = A1 * H + B1; Atot *= A0 * A1; }
        if (hi == 0) __hip_atomic_store(AGG2 + (size_t)chunk * 512 + ch, ((unsigned long long)__float_as_uint(H) << 32) | (unsigned long long)__float_as_uint(fmaxf(Atot, 1e-37f)),
                                        __ATOMIC_RELAXED, __HIP_MEMORY_SCOPE_AGENT);
    }
    { const int tidF = tid_of(wave); const unsigned long long* ag = AGG2 + tidF; float H = 0.f;
      for (int c = 0; c < chunk; c += 16) { unsigned long long v[16]; unsigned sp = 0;
          for (;;) { bool ok = true;
#pragma unroll
              for (int q = 0; q < 16; ++q) { const int cc = (c + q < chunk) ? c + q : chunk - 1; v[q] = __hip_atomic_load(ag + (size_t)cc * 512, __ATOMIC_RELAXED, __HIP_MEMORY_SCOPE_AGENT); ok = ok && ((unsigned)v[q] != 0u); }
              if (ok) break;
              __builtin_amdgcn_s_sleep(2); if (++sp > (1u << 22)) break; }
#pragma unroll
          for (int q = 0; q < 16; ++q) H = (c + q < chunk) ? __uint_as_float((unsigned)v[q]) * H + __uint_as_float((unsigned)(v[q] >> 32)) : H; }
      ((LAS float*)(lds + LRU_CARRY))[tidF] = H; }
    const bf16_t* YG = (const bf16_t*)(A.ws + WS_YG);
    u32x4 yv[8];
#pragma unroll
    for (int it = 0; it < 8; ++it) { const int laneY = tid_of(wave) & 63; yv[it] = *(const u32x4*)(YG + (R0 + it * 8 + (laneY >> 3)) * 512 + n * 64 + (laneY & 7) * 8); }
    __syncthreads();
    LAS float* stage = (LAS float*)wreg;
    const int tid3 = tid_of(wave); const int hi3 = (tid3 >> 5) & 1;
#pragma unroll
    for (int nt = 0; nt < 2; ++nt) {
        const int e = 32 * nt + r32, ch = n * 64 + e;
        float H = ((const LAS float*)(lds + LRU_CARRY))[ch];
#pragma unroll
        for (int gi = 0; gi < 8; ++gi) { const int mt = gi >> 2, i = gi & 3; float a = 1.f, bq = 0.f;
#pragma unroll
            for (int j = 0; j < 4; ++j) { const float aa = Av[nt][mt][4 * i + j]; bq = aa * bq + Bv[nt][mt][4 * i + j]; a *= aa; }
            const auto ra = __builtin_amdgcn_permlane32_swap(__float_as_uint(a), __float_as_uint(a), false, false); const auto rb = __builtin_amdgcn_permlane32_swap(__float_as_uint(bq), __float_as_uint(bq), false, false);
            const float A0 = __uint_as_float(ra[0]), A1 = __uint_as_float(ra[1]), B0 = __uint_as_float(rb[0]), B1 = __uint_as_float(rb[1]);
            const float h0 = H; H = A0 * H + B0; const float h1 = H; H = A1 * H + B1;
            float h = hi3 ? h1 : h0;
#pragma unroll
            for (int j = 0; j < 4; ++j) { h = Av[nt][mt][4 * i + j] * h + Bv[nt][mt][4 * i + j]; stage[(32 * mt + 8 * i + 4 * hi3 + j) * 68 + e] = h; } }
    }
    LDS_WAIT(); asm volatile("" ::: "memory");
    { bf16_t* AB = (bf16_t*)(A.ws + WS_AB); const int laneO = tid_of(wave) & 63;
      LAS float* xss = (LAS float*)(lds + LRU_XSS);
      f32x4 v[8][2];
#pragma unroll
      for (int it = 0; it < 8; ++it) { const int row = it * 8 + (laneO >> 3), c8 = laneO & 7;
          const f32x4 h0 = *(const LAS f32x4*)(stage + row * 68 + c8 * 8), h1 = *(const LAS f32x4*)(stage + row * 68 + c8 * 8 + 4);
          const u32x4 y = yv[it];
          v[it][0] = h0 * (f32x4){bflo(y.x), bfhi(y.x), bflo(y.y), bfhi(y.y)}; v[it][1] = h1 * (f32x4){bflo(y.z), bfhi(y.z), bflo(y.w), bfhi(y.w)};
          float ss = (v[it][0].x * v[it][0].x + v[it][0].y * v[it][0].y) + (v[it][0].z * v[it][0].z + v[it][0].w * v[it][0].w)
                   + (v[it][1].x * v[it][1].x + v[it][1].y * v[it][1].y) + (v[it][1].z * v[it][1].z + v[it][1].w * v[it][1].w);
          ss += __uint_as_float(__builtin_amdgcn_update_dpp(0u, __float_as_uint(ss), 0xB1, 0xF, 0xF, false)); ss += __uint_as_float(__builtin_amdgcn_update_dpp(0u, __float_as_uint(ss), 0x4E, 0xF, 0xF, false)); ss += __uint_as_float(__builtin_amdgcn_update_dpp(0u, __float_as_uint(ss), 0x141, 0xF, 0xF, false));
          if (c8 == 0) xss[row * 8 + wave] = ss; }
      __syncthreads();
#pragma unroll
      for (int it = 0; it < 8; ++it) { const int row = it * 8 + (laneO >> 3), c8 = laneO & 7;
          const f32x4 p0 = *(const LAS f32x4*)(xss + row * 8), p1 = *(const LAS f32x4*)(xss + row * 8 + 4);
          const float tot = ((((((p0.x + p0.y) + p0.z) + p0.w) + p1.x) + p1.y) + p1.z) + p1.w;
          const float ri = __builtin_amdgcn_rsqf(tot * (1.f / 512.f) + EPS_);
          const f32x4 a = v[it][0] * ri, c = v[it][1] * ri;
          u32x4 o; o.x = pk2(a.x, a.y); o.y = pk2(a.z, a.w); o.z = pk2(c.x, c.y); o.w = pk2(c.z, c.w);
          *(u32x4*)(AB + (R0 + row) * 1024 + 512 + n * 64 + c8 * 8) = o; }
      __syncthreads(); }
}

constexpr int NS_KV = 0, NS_KC = 0, NS_VC = 18432, NS_IMP = 35840;
constexpr int NS_OSP = 0, NS_LSP = 66560, NS_MREF = 67584, NS_QT = 69632, NS_SLOT = 102400;
constexpr int NS_SEL = 103936, NS_LUT = 104960, NS_SS = 111104, NS_ATT = 111616, NS_QCTR = 145408;
constexpr int LUTN = 192;
constexpr int OSPP = 65;
constexpr int KPITCH = 144;
constexpr int VCPITCH = 272;
constexpr int IMPP = 132;
constexpr int ATTP = 264;


struct SoftSt { float m, l; f32x16 o[2]; };
#define MX3(a, b, c) __builtin_fmaxf(__builtin_fmaxf((a), (b)), (c))
__device__ __forceinline__ void attn_step(const LAS unsigned char* Kt, const LAS unsigned char* Vt, const bf16x8 (&qr)[4], float cinit, bool masked, bool first,
                                          int tq, int kpos0, int lo_excl, const LAS float* lut_h, SoftSt& st, int r32, int hi) {
    bf16x8 kf[2][4];
#pragma unroll
    for (int kt = 0; kt < 2; ++kt)
#pragma unroll
        for (int ds = 0; ds < 4; ++ds) kf[kt][ds] = *(const LAS bf16x8*)(Kt + (32 * kt + r32) * KPITCH + (16 * ds + 8 * hi) * 2);
    __builtin_amdgcn_sched_barrier(0);
    f32x16 sc[2], cvec;
    const float c0 = cinit - st.m;
#pragma unroll
    for (int r = 0; r < 16; ++r) cvec[r] = c0;
#pragma unroll
    for (int ds = 0; ds < 4; ++ds)
#pragma unroll
        for (int kt = 0; kt < 2; ++kt) sc[kt] = __builtin_amdgcn_mfma_f32_32x32x16_bf16(kf[kt][ds], qr[ds], ds == 0 ? cvec : sc[kt], 0, 0, 0);
    bf16x8 vf[2][2][2];
#pragma unroll
    for (int kt = 0; kt < 2; ++kt)
#pragma unroll
        for (int s = 0; s < 2; ++s)
#pragma unroll
            for (int dt = 0; dt < 2; ++dt) vf[kt][s][dt] = *(const LAS bf16x8*)(Vt + (32 * dt + r32) * KPITCH + (32 * kt + 16 * s + 8 * hi) * 2);
    __builtin_amdgcn_sched_barrier(0);
    if (masked) {
#pragma unroll
        for (int kt = 0; kt < 2; ++kt) { float bv[16];
            asm volatile("" ::: "memory");
#pragma unroll
            for (int r = 0; r < 16; ++r) { const int dist = tq - (kpos0 + 32 * kt + crow(r, hi)); const int di = dist < 0 ? 0 : (dist > LUTN - 1 ? LUTN - 1 : dist); bv[r] = lut_h[di]; }
#pragma unroll
            for (int r = 0; r < 16; ++r) { const int pos = kpos0 + 32 * kt + crow(r, hi); const bool ok = (tq >= pos) && (pos > lo_excl); sc[kt][r] = ok ? sc[kt][r] + bv[r] : NEG_; } }
    }
    float mx = MX3(sc[0][0], sc[1][0], sc[0][1]);
#pragma unroll
    for (int r = 2; r < 16; r += 2) mx = MX3(mx, sc[0][r], sc[1][r - 1]), mx = MX3(mx, sc[0][r + 1], sc[1][r]);
    mx = fmaxf(mx, sc[1][15]);
    mx = fmaxf(mx, shx(mx, 32));
    if (first || __any(mx > 8.0f)) { const float dl = first ? mx : fmaxf(mx, 0.f); const float corr = ex2(-dl); st.m += dl; st.l *= corr;
#pragma unroll
        for (int kt = 0; kt < 2; ++kt)
#pragma unroll
            for (int r = 0; r < 16; ++r) { sc[kt][r] -= dl; st.o[kt][r] *= corr; } }
    f32x2 ls2 = {0.f, 0.f};
#pragma unroll
    for (int kt = 0; kt < 2; ++kt)
#pragma unroll
        for (int s = 0; s < 2; ++s) {
#pragma unroll
            for (int j = 0; j < 8; j += 2) { const float e0 = ex2(sc[kt][8 * s + j]), e1 = ex2(sc[kt][8 * s + j + 1]); sc[kt][8 * s + j] = e0; sc[kt][8 * s + j + 1] = e1; ls2 += (f32x2){e0, e1}; }
            u32x4 pw; pw.x = cvt_pk_bf16(sc[kt][8 * s + 0], sc[kt][8 * s + 1]); pw.y = cvt_pk_bf16(sc[kt][8 * s + 2], sc[kt][8 * s + 3]);
            pw.z = cvt_pk_bf16(sc[kt][8 * s + 4], sc[kt][8 * s + 5]); pw.w = cvt_pk_bf16(sc[kt][8 * s + 6], sc[kt][8 * s + 7]);
            const bf16x8 pf = __builtin_bit_cast(bf16x8, pw);
#pragma unroll
            for (int dt = 0; dt < 2; ++dt) st.o[dt] = __builtin_amdgcn_mfma_f32_32x32x16_bf16(vf[kt][s][dt], pf, st.o[dt], 0, 0, 0); }
    st.l += ls2.x + ls2.y;
}

#define NSA_IDS() const int tid = tid_of(wave); const int lane = tid & 63, r32 = lane & 31, hi = lane >> 5; const int tl = 8 * wave + (r32 >> 2), hh = r32 & 3; \
    const int tq = 64 * tile + tl; const size_t R = rowbase + tq; const int hg = g * 4 + hh; const LAS float* lut_h = (const LAS float*)(lds + NS_LUT) + hg * LUTN; (void)lane; (void)R; (void)lut_h; (void)tq; (void)hi
#define NSA_LOADQ() bf16x8 qr[4]; _Pragma("unroll") for (int ds = 0; ds < 4; ++ds) qr[ds] = *(const LAS bf16x8*)(lds + NS_QT + (32 * wave + r32) * 128 + (((2 * ds + hi) ^ (r32 & 7)) << 4))

template <int variant>
__device__ __forceinline__ void nsa_item(const Args& A, int l, int b, int tile, LAS unsigned char* lds, int wave) {
    const int cur = tile; const size_t rowbase = (size_t)b * S_;
    const int nkb = cur >= 64 ? 2 : 1;
#pragma unroll 1
    for (int g = 0; g < 2; ++g) {
        float gate3[3];
        { NSA_IDS(); const float* gp = (const float*)(A.ws + WS_GATES) + R * 24 + hg * 3; gate3[0] = gp[0]; gate3[1] = gp[1]; gate3[2] = gp[2]; }
        {
            NSA_IDS();
            LAS float* imp = (LAS float*)(lds + NS_IMP);
            { const bf16_t* kcb = (const bf16_t*)(A.ws + WS_KCB) + (size_t)(g * 4 + b) * 128 * 64; const bf16_t* vct = (const bf16_t*)(A.ws + WS_VCT) + (size_t)(g * 4 + b) * 8192;
              u32x4 kv[2], vv[2], qv[4];
#pragma unroll
              for (int i = 0; i < 2; ++i) { const int idx = tid + NTHREADS * i; kv[i] = *(const u32x4*)(kcb + idx * 8); vv[i] = *(const u32x4*)(vct + idx * 8); }
#pragma unroll
              for (int i = 0; i < 4; ++i) { const int idx = tid + NTHREADS * i; const int row = idx >> 3, c = idx & 7;
                  qv[i] = *(const u32x4*)((const bf16_t*)(A.ws + WS_QB) + (rowbase + 64 * tile + (row >> 2)) * 512 + (g * 4 + (row & 3)) * 64 + c * 8); }
#pragma unroll
              for (int i = 0; i < 4; ++i) { const int idx = tid + NTHREADS * i; const int row = idx >> 3, c = idx & 7; *(LAS u32x4*)(lds + NS_QT + row * 128 + ((c ^ (row & 7)) << 4)) = qv[i]; }
#pragma unroll
              for (int i = 0; i < 2; ++i) { const int idx = tid + NTHREADS * i;
                  *(LAS u32x4*)(lds + NS_KC + (idx >> 3) * KPITCH + (idx & 7) * 16) = kv[i];
                  *(LAS u32x4*)(lds + NS_VC + (idx >> 4) * VCPITCH + (idx & 15) * 16) = vv[i]; } }
            __syncthreads();
            NSA_LOADQ();
            const float b31c = lut_h[LUTN - 1];
            f32x16 pc[4];
            float mx = NEG_;
#pragma unroll
            for (int kq = 0; kq < 4; ++kq) {
#pragma unroll
                for (int r = 0; r < 16; ++r) pc[kq][r] = NEG_;
                if (kq < 2 * nkb) {
                    f32x16 p = {};
#pragma unroll
                    for (int ds = 0; ds < 4; ++ds) { const bf16x8 kf = *(const LAS bf16x8*)(lds + NS_KC + (32 * kq + r32) * KPITCH + (16 * ds + 8 * hi) * 2);
                        p = __builtin_amdgcn_mfma_f32_32x32x16_bf16(kf, qr[ds], p, 0, 0, 0); }
                    if (32 * kq + 31 >= cur - 2) {
#pragma unroll
                        for (int r = 0; r < 16; ++r) { const int j = 32 * kq + crow(r, hi); const int dist = tq - (64 * j + 63); const bool ok = dist >= 0;
                            const int di = dist < 0 ? 0 : (dist > LUTN - 1 ? LUTN - 1 : dist);
                            const float sv = ok ? p[r] + lut_h[di] : NEG_; pc[kq][r] = sv; mx = fmaxf(mx, sv); }
                    } else {
#pragma unroll
                        for (int r = 0; r < 16; ++r) { const float sv = p[r] + b31c; pc[kq][r] = sv; mx = fmaxf(mx, sv); } }
                } }
            { const auto rr = __builtin_amdgcn_permlane32_swap(__float_as_uint(mx), __float_as_uint(mx), false, false); mx = fmaxf(__uint_as_float(rr[0]), __uint_as_float(rr[1])); }
            float lsum = 0.f;
#pragma unroll
            for (int kq = 0; kq < 4; ++kq)
#pragma unroll
                for (int r = 0; r < 16; ++r) { const float e = (pc[kq][r] > -1e29f) ? ex2(pc[kq][r] - mx) : 0.f; pc[kq][r] = e; lsum += e; }
            { const auto rr = __builtin_amdgcn_permlane32_swap(__float_as_uint(lsum), __float_as_uint(lsum), false, false); lsum = __uint_as_float(rr[0]) + __uint_as_float(rr[1]); }
            const float inv = rcp(fmaxf(lsum, 1e-30f));
            f32x16 oc[2] = {};
#pragma unroll
            for (int kq = 0; kq < 4; ++kq) {
                if (kq < 2 * nkb) {
#pragma unroll
                    for (int r = 0; r < 16; ++r) pc[kq][r] *= inv;
#pragma unroll
                    for (int s2 = 0; s2 < 2; ++s2) {
                        u32x4 pw; pw.x = cvt_pk_bf16(pc[kq][8 * s2 + 0], pc[kq][8 * s2 + 1]); pw.y = cvt_pk_bf16(pc[kq][8 * s2 + 2], pc[kq][8 * s2 + 3]);
                        pw.z = cvt_pk_bf16(pc[kq][8 * s2 + 4], pc[kq][8 * s2 + 5]); pw.w = cvt_pk_bf16(pc[kq][8 * s2 + 6], pc[kq][8 * s2 + 7]);
                        const bf16x8 pf = __builtin_bit_cast(bf16x8, pw);
#pragma unroll
                        for (int dt = 0; dt < 2; ++dt) { const LAS unsigned char* vp = lds + NS_VC + (32 * dt + r32) * VCPITCH + (32 * kq + 16 * s2 + 4 * hi) * 2;
                            const u32x2 lo = *(const LAS u32x2*)vp, hi8 = *(const LAS u32x2*)(vp + 16);
                            const u32x4 vw = {lo.x, lo.y, hi8.x, hi8.y};
                            oc[dt] = __builtin_amdgcn_mfma_f32_32x32x16_bf16(__builtin_bit_cast(bf16x8, vw), pf, oc[dt], 0, 0, 0); } }
#pragma unroll
                    for (int r = 0; r < 16; ++r) { float v = pc[kq][r];
                        v += __uint_as_float(__builtin_amdgcn_update_dpp(0u, __float_as_uint(v), 0xB1, 0xF, 0xF, false)); v += __uint_as_float(__builtin_amdgcn_update_dpp(0u, __float_as_uint(v), 0x4E, 0xF, 0xF, false));
                        if (hh == 0) imp[tl * IMPP + 32 * kq + crow(r, hi)] = v; }
                } }
            const float gc = gate3[0];
            { LAS bf16_t* att = (LAS bf16_t*)(lds + NS_ATT);
#pragma unroll
              for (int dt = 0; dt < 2; ++dt)
#pragma unroll
                for (int q4 = 0; q4 < 4; ++q4) { u32x2 w; w.x = pk2(gc * oc[dt][4 * q4 + 0], gc * oc[dt][4 * q4 + 1]); w.y = pk2(gc * oc[dt][4 * q4 + 2], gc * oc[dt][4 * q4 + 3]);
                    *(LAS u32x2*)(att + tl * ATTP + hh * 64 + 32 * dt + 8 * q4 + 4 * hi) = w; } }
            __syncthreads();
        }
        u32x4 pk, pv;
        { const int tidp = tid_of(wave); const int trow = tidp >> 3, tch = (tidp & 7) * 8;
          pk = *(const u32x4*)((const bf16_t*)(A.ws + WS_KP) + (size_t)(1 * 2 + g) * T_ * 64 + (rowbase + trow) * 64 + tch);
          pv = *(const u32x4*)((const bf16_t*)(A.ws + WS_VT) + (size_t)(1 * 128 + g * 64) * T_ + (size_t)trow * T_ + rowbase + tch); }
        {
            const int tid = tid_of(wave);
            const LAS float* imp = (const LAS float*)(lds + NS_IMP); LAS unsigned short* sel16 = (LAS unsigned short*)(lds + NS_SEL);
            const int tk = tid >> 3, sub = tid & 7, jb = sub * 16;
            const int need = 16 - (cur + 1 < 3 ? cur + 1 : 3);
            unsigned key[16];
#pragma unroll
            for (int c = 0; c < 16; ++c) { const int j = jb + c; const bool cand = (j >= 1) && (j <= cur - 2); const float v = (j < nkb * 64) ? imp[tk * IMPP + j] : 0.f; key[c] = cand ? __float_as_uint(v) + 1u : 0u; }
            unsigned T = 0u;
#pragma unroll 1
            for (int bit = 30; bit >= 0; --bit) { const unsigned t = T | (1u << bit); int cnt = 0;
#pragma unroll
                for (int c = 0; c < 16; ++c) cnt += (key[c] >= t) ? 1 : 0;
                cnt += __builtin_amdgcn_update_dpp(0, cnt, 0xB1, 0xF, 0xF, false); cnt += __builtin_amdgcn_update_dpp(0, cnt, 0x4E, 0xF, 0xF, false); cnt += __builtin_amdgcn_update_dpp(0, cnt, 0x141, 0xF, 0xF, false);
                if (cnt >= need) T = t;
                if (cnt == need) break; }
            int ngt = 0, neq = 0;
#pragma unroll
            for (int c = 0; c < 16; ++c) { ngt += (key[c] > T) ? 1 : 0; neq += (key[c] == T && T != 0u) ? 1 : 0; }
            int ngt_all = ngt; ngt_all += __builtin_amdgcn_update_dpp(0, ngt_all, 0xB1, 0xF, 0xF, false); ngt_all += __builtin_amdgcn_update_dpp(0, ngt_all, 0x4E, 0xF, 0xF, false); ngt_all += __builtin_amdgcn_update_dpp(0, ngt_all, 0x141, 0xF, 0xF, false);
            int pre = neq;
            { int t1 = shup8(pre, 1); if (sub >= 1) pre += t1; int t2 = shup8(pre, 2); if (sub >= 2) pre += t2; int t4 = shup8(pre, 4); if (sub >= 4) pre += t4; pre -= neq; }
            const int rem = need - ngt_all;
            unsigned mask = 0; int run = pre;
#pragma unroll
            for (int c = 0; c < 16; ++c) { const int j = jb + c; const bool forced = (j == 0) || (j == cur) || (j == cur - 1); bool sel = key[c] > T;
                if (key[c] == T && T != 0u) { sel = run < rem; ++run; }
                if (sel || forced) mask |= (1u << c); }
            sel16[tk * 8 + sub] = (unsigned short)mask;
            __syncthreads();
        }
#pragma unroll 1
        for (int br = 0; br < 2; ++br) {
            NSA_IDS();
            NSA_LOADQ();
            const float b31 = lut_h[LUTN - 1];
            const LAS unsigned* selw = (const LAS unsigned*)(lds + NS_SEL) + tl * 4;
            const bf16_t* Kp = (const bf16_t*)(A.ws + WS_KP) + (size_t)((br == 0 ? 1 : 2) * 2 + g) * T_ * 64;
            const bf16_t* Vp = (const bf16_t*)(A.ws + WS_VT) + (size_t)((br == 0 ? 1 : 2) * 128 + g * 64) * T_;
            const int nblk = br == 0 ? (cur + 1 < 4 ? cur + 1 : 4) : (cur < 8 ? cur + 1 : 9);
#define KBI(i_) (br == 0 ? ((i_) == 0 ? 0 : cur - (nblk - 1 - (i_))) : cur - (i_))
            SoftSt st; st.m = 0.f; st.l = 0.f; st.o[0] = (f32x16){}; st.o[1] = (f32x16){};
            const int trow = tid >> 3, tch = (tid & 7) * 8;
            const bf16_t* kg = Kp + (rowbase + trow) * 64 + tch;
            const bf16_t* vg = Vp + (size_t)trow * T_ + rowbase + tch;
            LAS unsigned char* kl = lds + NS_KV + trow * KPITCH + tch * 2;
            LAS unsigned char* vl = lds + NS_KV + trow * KPITCH + ((tch >> 4) * 16 + ((tch >> 3) & 1) * 4) * 2;
#define NSA_LD(kr, vr, i_) asm volatile("global_load_dwordx4 %0, %2, off\n\tglobal_load_dwordx4 %1, %3, off" : "=&v"(kr), "=&v"(vr) : "v"(kg + (long)KBC(i_) * 4096), "v"(vg + (long)KBC(i_) * 64) : "memory")
#define NSA_WAIT(kr, vr, n) asm volatile("s_waitcnt vmcnt(" #n ")" : "+v"(kr), "+v"(vr) : : "memory")
#define NSA_ST(kr, vr, i_) do { *(LAS u32x4*)(kl + ((i_) & 1) * 18432) = kr; \
                *(LAS u32x2*)(vl + ((i_) & 1) * 18432 + 9216) = (u32x2){vr.x, vr.y}; *(LAS u32x2*)(vl + ((i_) & 1) * 18432 + 9216 + 16) = (u32x2){vr.z, vr.w}; } while (0)
#define NSA_STEP(i_) do { const int kb = KBI(i_); const bool masked = (cur - kb <= 2) || (br == 1 && cur - kb == 8); bool selected = true; \
                if (br == 0) selected = (selw[kb >> 5] >> (kb & 31)) & 1u; \
                if (__ballot(selected) != 0ull) { const float cinit = selected ? (masked ? 0.f : b31) : NEG_; \
                    attn_step(lds + NS_KV + ((i_) & 1) * 18432, lds + NS_KV + ((i_) & 1) * 18432 + 9216, qr, cinit, masked, (i_) == 0, tq, 64 * kb, br == 1 ? tq - 512 : -1, lut_h, st, r32, hi); } } while (0)
#define KBC(i_) KBI((i_) < nblk ? (i_) : nblk - 1)
            u32x4 kA, vA, kB, vB;
            asm volatile("" : "+v"(qr[0]), "+v"(qr[1]), "+v"(qr[2]), "+v"(qr[3]));
            kA = pk; vA = pv; NSA_ST(kA, vA, 0);
            NSA_LD(kA, vA, 1); NSA_LD(kB, vB, 2);
            __syncthreads();
#pragma unroll 1
            for (int i = 0; i < nblk; i += 2) {
                NSA_STEP(i);
                NSA_WAIT(kA, vA, 2); NSA_ST(kA, vA, 1); NSA_LD(kA, vA, i + 3);
                __syncthreads();
                if (i + 1 >= nblk) break;
                NSA_STEP(i + 1);
                NSA_WAIT(kB, vB, 2); NSA_ST(kB, vB, 0); NSA_LD(kB, vB, i + 4);
                __syncthreads();
            }
            asm volatile("s_waitcnt vmcnt(0)" : "+v"(kA), "+v"(vA), "+v"(kB), "+v"(vB) : : "memory");
            if (br == 0) {
                pk = *(const u32x4*)((const bf16_t*)(A.ws + WS_KP) + (size_t)(2 * 2 + g) * T_ * 64 + (rowbase + trow) * 64 + tch + (long)cur * 4096);
                pv = *(const u32x4*)((const bf16_t*)(A.ws + WS_VT) + (size_t)(2 * 128 + g * 64) * T_ + (size_t)trow * T_ + rowbase + tch + (long)cur * 64); }
#undef KBC
#undef NSA_LD
#undef NSA_WAIT
#undef NSA_ST
#undef NSA_STEP
#undef KBI
            if (br == 0 && cur >= 4) {
                LAS float* osp = (LAS float*)(lds + NS_OSP); LAS float* lsp = (LAS float*)(lds + NS_LSP); LAS float* mrf = (LAS float*)(lds + NS_MREF);
                { f32x4 z = {0.f, 0.f, 0.f, 0.f};
                  for (int i = tid; i < 4224; i += NTHREADS) *(LAS f32x4*)(lds + NS_OSP + i * 16) = z; }
                LAS float* scl = (LAS float*)(lds + NS_SLOT + 512);
                { const float ld = st.l + shx(st.l, 32); const int e_ = (int)((__float_as_uint(fmaxf(ld, 1e-30f)) >> 23) & 255u) - 126;
                  if (hi == 0) { mrf[32 * wave + r32] = st.m - (float)(20 - e_); scl[32 * wave + r32] = __uint_as_float((unsigned)(127 + 20 - e_) << 23); } }
                if (tid == 0) *(LAS int*)(lds + NS_QCTR) = 1;
                __syncthreads();
                const bf16_t* Kf1 = (const bf16_t*)(A.ws + WS_KF) + ((size_t)g * (T_ / 64) + (rowbase >> 6)) * 4096 + lane * 8;
                const bf16_t* Vf1 = (const bf16_t*)(A.ws + WS_VF) + ((size_t)g * (T_ / 64) + (rowbase >> 6)) * 4096 + lane * 8;
                LAS unsigned char* slot = lds + NS_SLOT + wave * 64;
                const LAS unsigned* selm = (const LAS unsigned*)(lds + NS_SEL);
                LAS int* qctr = (LAS int*)(lds + NS_QCTR);
#pragma unroll 1
                for (;;) {
                    int kbv = 0; if (lane == 0) kbv = __hip_atomic_fetch_add(qctr, 1, __ATOMIC_RELAXED, __HIP_MEMORY_SCOPE_WORKGROUP);
                    const int kb = __builtin_amdgcn_readfirstlane(kbv);
                    if (kb > cur - 3) break;
                    const bool bit = (selm[lane * 4 + (kb >> 5)] >> (kb & 31)) & 1u;
                    const unsigned long long msk = __ballot(bit); const int cnt = __popcll(msk);
                    if (cnt == 0) continue;
                    if (bit) slot[__builtin_amdgcn_mbcnt_hi((unsigned)(msk >> 32), __builtin_amdgcn_mbcnt_lo((unsigned)msk, 0u))] = (unsigned char)lane;
                    bf16x8 kf[2][4], vf[2][2][2];
#pragma unroll
                    for (int kt = 0; kt < 2; ++kt)
#pragma unroll
                        for (int ds = 0; ds < 4; ++ds) kf[kt][ds] = *(const bf16x8*)(Kf1 + (size_t)kb * 4096 + (kt * 4 + ds) * 512);
#pragma unroll
                    for (int kt = 0; kt < 2; ++kt)
#pragma unroll
                        for (int s2 = 0; s2 < 2; ++s2)
#pragma unroll
                            for (int dt = 0; dt < 2; ++dt) vf[kt][s2][dt] = *(const bf16x8*)(Vf1 + (size_t)kb * 4096 + ((kt * 2 + s2) * 2 + dt) * 512);
                    LDS_WAIT(); asm volatile("" ::: "memory");
#pragma unroll 1
                    for (int c8 = 0; c8 * 8 < cnt; ++c8) {
                        const int si = c8 * 8 + (r32 >> 2); const bool valid = si < cnt; const int tok = slot[valid ? si : 0]; const int row = tok * 4 + hh;
                        bf16x8 qf[4];
#pragma unroll
                        for (int ds = 0; ds < 4; ++ds) qf[ds] = *(const LAS bf16x8*)(lds + NS_QT + row * 128 + (((2 * ds + hi) ^ (row & 7)) << 4));
                        const float c0 = valid ? b31 - mrf[row] : NEG_;
                        f32x16 sc[2], cvec;
#pragma unroll
                        for (int r = 0; r < 16; ++r) cvec[r] = c0;
#pragma unroll
                        for (int ds = 0; ds < 4; ++ds)
#pragma unroll
                            for (int kt = 0; kt < 2; ++kt) sc[kt] = __builtin_amdgcn_mfma_f32_32x32x16_bf16(kf[kt][ds], qf[ds], ds == 0 ? cvec : sc[kt], 0, 0, 0);
                        f32x2 ls2 = {0.f, 0.f}; f32x16 ot[2] = {};
#pragma unroll
                        for (int kt = 0; kt < 2; ++kt)
#pragma unroll
                            for (int s2 = 0; s2 < 2; ++s2) {
#pragma unroll
                                for (int j = 0; j < 8; j += 2) { const float e0 = ex2(fminf(sc[kt][8 * s2 + j], 44.0f)), e1 = ex2(fminf(sc[kt][8 * s2 + j + 1], 44.0f)); sc[kt][8 * s2 + j] = e0; sc[kt][8 * s2 + j + 1] = e1; ls2 += (f32x2){e0, e1}; }
                                u32x4 pw; pw.x = cvt_pk_bf16(sc[kt][8 * s2 + 0], sc[kt][8 * s2 + 1]); pw.y = cvt_pk_bf16(sc[kt][8 * s2 + 2], sc[kt][8 * s2 + 3]);
                                pw.z = cvt_pk_bf16(sc[kt][8 * s2 + 4], sc[kt][8 * s2 + 5]); pw.w = cvt_pk_bf16(sc[kt][8 * s2 + 6], sc[kt][8 * s2 + 7]);
                                const bf16x8 pf = __builtin_bit_cast(bf16x8, pw);
#pragma unroll
                                for (int dt = 0; dt < 2; ++dt) ot[dt] = __builtin_amdgcn_mfma_f32_32x32x16_bf16(vf[kt][s2][dt], pf, ot[dt], 0, 0, 0); }
                        float ls = ls2.x + ls2.y;
                        { const auto rr = __builtin_amdgcn_permlane32_swap(__float_as_uint(ls), __float_as_uint(ls), false, false); ls = __uint_as_float(rr[0]) + __uint_as_float(rr[1]); }
                        if (valid) {
#pragma unroll
                            for (int dt = 0; dt < 2; ++dt)
#pragma unroll
                                for (int r = 0; r < 16; ++r) __hip_atomic_fetch_add((LAS int*)osp + row * OSPP + 32 * dt + crow(r, hi), (int)__builtin_amdgcn_fmed3f(ot[dt][r], -6.0e7f, 6.0e7f), __ATOMIC_RELAXED, __HIP_MEMORY_SCOPE_WORKGROUP);
                            if (hi == 0) __hip_atomic_fetch_add((LAS int*)lsp + row, (int)fminf(ls, 6.0e7f), __ATOMIC_RELAXED, __HIP_MEMORY_SCOPE_WORKGROUP); }
                    }
                }
                __syncthreads();
                { const int row = 32 * wave + r32; const float isr = rcp(scl[row]);
#pragma unroll
                  for (int dt = 0; dt < 2; ++dt)
#pragma unroll
                    for (int r = 0; r < 16; ++r) st.o[dt][r] += (float)((const LAS int*)osp)[row * OSPP + 32 * dt + crow(r, hi)] * isr;
                  if (hi == 0) st.l += (float)((const LAS int*)lsp)[row] * isr; }
                __syncthreads();
            }
            const float lt = st.l + shx(st.l, 32);
            const float gg = (br == 0 ? gate3[1] : gate3[2]) * rcp(lt);
            LAS bf16_t* att = (LAS bf16_t*)(lds + NS_ATT);
            float ss = 0.f;
#pragma unroll
            for (int dt = 0; dt < 2; ++dt)
#pragma unroll
                for (int q4 = 0; q4 < 4; ++q4) { LAS u32x2* ap = (LAS u32x2*)(att + tl * ATTP + hh * 64 + 32 * dt + 8 * q4 + 4 * hi); const u32x2 pv = *ap;
                    const float a0 = bflo(pv.x) + gg * st.o[dt][4 * q4 + 0], a1 = bfhi(pv.x) + gg * st.o[dt][4 * q4 + 1], a2 = bflo(pv.y) + gg * st.o[dt][4 * q4 + 2], a3 = bfhi(pv.y) + gg * st.o[dt][4 * q4 + 3];
                    ss += (a0 * a0 + a1 * a1) + (a2 * a2 + a3 * a3);
                    u32x2 w; w.x = pk2(a0, a1); w.y = pk2(a2, a3); *ap = w; }
            if (br == 1) { ss += shx(ss, 32); ss += shx(ss, 1); ss += shx(ss, 2);
                if (lane == (lane & 28)) ((LAS float*)(lds + NS_SS))[g * 64 + tl] = ss; }
        }
        __syncthreads();
        { const int tid = tid_of(wave);
          const LAS float* ssq = (const LAS float*)(lds + NS_SS); const LAS bf16_t* att = (const LAS bf16_t*)(lds + NS_ATT);
          bf16_t* AB = (bf16_t*)(A.ws + WS_AB);
#pragma unroll
          for (int it = 0; it < 4; ++it) { const int idx = it * NTHREADS + tid; const int row = idx >> 5, c8 = idx & 31;
              const float ri = g == 0 ? 1.0f : __builtin_amdgcn_rsqf((ssq[row] + ssq[64 + row]) * (1.f / 512.f) + EPS_);
              const u32x4 w = *(const LAS u32x4*)(att + row * ATTP + c8 * 8);
              u32x4 o; o.x = pk2(bflo(w.x) * ri, bfhi(w.x) * ri); o.y = pk2(bflo(w.y) * ri, bfhi(w.y) * ri); o.z = pk2(bflo(w.z) * ri, bfhi(w.z) * ri); o.w = pk2(bflo(w.w) * ri, bfhi(w.w) * ri);
              *(u32x4*)(AB + (rowbase + 64 * tile + row) * 1024 + g * 256 + c8 * 8) = o; }
          if (g == 1) {
#pragma unroll
              for (int it = 0; it < 4; ++it) { const int idx = it * NTHREADS + tid; const int row = idx >> 5, c8 = idx & 31;
                  const float ri = __builtin_amdgcn_rsqf((ssq[row] + ssq[64 + row]) * (1.f / 512.f) + EPS_);
                  u32x4* p = (u32x4*)(AB + (rowbase + 64 * tile + row) * 1024 + c8 * 8); const u32x4 w = *p;
                  u32x4 o; o.x = pk2(bflo(w.x) * ri, bfhi(w.x) * ri); o.y = pk2(bflo(w.y) * ri, bfhi(w.y) * ri); o.z = pk2(bflo(w.z) * ri, bfhi(w.z) * ri); o.w = pk2(bflo(w.w) * ri, bfhi(w.w) * ri);
                  *p = o; } }
        }
        __syncthreads();
    }
}

__device__ __forceinline__ void nsa_lut(const Args& A, LAS unsigned char* lds, int tid) {
    LAS float* lut = (LAS float*)(lds + NS_LUT);
    for (int i = tid; i < 8 * LUTN; i += NTHREADS) { const int h = i / LUTN, d = i % LUTN;
        int bk; if (d < 16) bk = d; else if (d >= 128) bk = 31; else { bk = 16 + (int)(logf((float)d * (1.0f / 16.0f)) / 2.0794415416798357f * 16.0f); bk = bk > 31 ? 31 : bk; }
        lut[i] = A.in[I_RELB][bk * 8 + h] * LOG2E_; }
    __syncthreads();
}

#define XB_TMO      128
#define XB_XCNT(j)  (256  + 64 * (j))
#define XB_XSUB(j)  (1280 + 64 * (j))
#define XB_XGEN(j)  (2304 + 64 * (j))
#define XB_TOP      3328
#define XB_TOPGEN   3392
#define XCD_BAR_WORDS 3456
#define XB_SPIN_CAP (1u << 20)
__device__ __forceinline__ unsigned xb_ld(unsigned* p)              { return __hip_atomic_load(p, __ATOMIC_RELAXED, __HIP_MEMORY_SCOPE_AGENT); }
__device__ __forceinline__ unsigned xb_add(unsigned* p, unsigned v) { return __hip_atomic_fetch_add(p, v, __ATOMIC_RELAXED, __HIP_MEMORY_SCOPE_AGENT); }
__device__ __forceinline__ unsigned xb_xcc_id() { return (unsigned)__builtin_amdgcn_s_getreg((3 << 11) | 20) & 0xFu; }
#define XB_SPIN(cond, bar) do { unsigned _sp = 0; while (cond) { __builtin_amdgcn_s_sleep(1); \
    if ((++_sp & 255u) == 0u) { if (xb_ld(&(bar)[XB_TMO])) break; if (_sp > XB_SPIN_CAP) { atomicAdd(&(bar)[XB_TMO], 1u); break; } } } } while (0)
struct XcdBarrier { unsigned* bar; unsigned x; volatile LAS unsigned* st; };
__device__ __forceinline__ XcdBarrier xcd_barrier_post(unsigned* bar, volatile LAS unsigned* st, bool leader) {
    XcdBarrier b; b.bar = bar; b.x = xb_xcc_id(); b.st = st;
    if (leader) (void)xb_add(&bar[XB_XCNT(b.x)], 1u);
    return b;
}
__device__ __forceinline__ void xcd_barrier_complete(unsigned* bar, unsigned x, unsigned& nloc, unsigned& nx) {
    const unsigned G = gridDim.x * gridDim.y * gridDim.z;
    unsigned sum, cnt, mine, sp = 0u;
    for (;;) {
        sum = 0u; cnt = 0u; mine = 0u;
#pragma unroll
        for (unsigned j = 0; j < 16; ++j) { const unsigned c = xb_ld(&bar[XB_XCNT(j)]); sum += c; cnt += (c > 0u) ? 1u : 0u; mine = (j == x) ? c : mine; }
        if (sum == G) break;
        __builtin_amdgcn_s_sleep(1);
        if ((++sp & 255u) == 0u) { if (xb_ld(&bar[XB_TMO])) break; if (sp > XB_SPIN_CAP) { atomicAdd(&bar[XB_TMO], 1u); break; } }
    }
    nloc = mine > 0u ? mine : 1u; nx = cnt > 0u ? cnt : 1u;
}
__device__ __forceinline__ void xcd_barrier(const XcdBarrier& b, bool leader) {
    asm volatile("s_waitcnt vmcnt(0)" ::: "memory");
    __syncthreads();
    if (leader) {
        unsigned* bar = b.bar;
        __builtin_amdgcn_s_waitcnt(0);
        unsigned nloc = b.st[0], nx = b.st[1];
        if (nloc == 0u) { xcd_barrier_complete(bar, b.x, nloc, nx); b.st[0] = nloc; b.st[1] = nx; }
        const unsigned old = xb_add(&bar[XB_XSUB(b.x)], 1u);
        const unsigned gen = old / nloc;
        if (old + 1u == (gen + 1u) * nloc) {
            __builtin_amdgcn_fence(__ATOMIC_RELEASE, "agent");
            asm volatile("s_waitcnt vmcnt(0)" ::: "memory");
            const unsigned og = xb_add(&bar[XB_TOP], 1u);
            __builtin_amdgcn_fence(__ATOMIC_ACQUIRE, "agent");
            const unsigned tg = og / nx;
            if (og + 1u == (tg + 1u) * nx) xb_add(&bar[XB_TOPGEN], 1u);
            else XB_SPIN(xb_ld(&bar[XB_TOPGEN]) == tg, bar);
            xb_add(&bar[XB_XGEN(b.x)], 1u);
            asm volatile("s_waitcnt vmcnt(0)" ::: "memory");
        } else {
            __builtin_amdgcn_fence(__ATOMIC_ACQUIRE, "agent");
            XB_SPIN(xb_ld(&bar[XB_XGEN(b.x)]) == gen, bar);
            asm volatile("s_waitcnt vmcnt(0)" ::: "memory");
        }
    }
    __syncthreads();
}

constexpr int NPH = 1 + 9 * NL_;
#ifndef PH_MASK
#define PH_MASK 0xFFFF
#endif
#define PHON(k) (((PH_MASK) >> (k)) & 1)
#ifndef REPEAT_MASK
#define REPEAT_MASK 0
#endif
__global__ void __launch_bounds__(NTHREADS, 2) trunk_fwd(Args args) {
    extern __shared__ __attribute__((aligned(16))) unsigned char lds_raw[];
    LAS unsigned char* lds = (LAS unsigned char*)lds_raw;
    cg::grid_group grid = cg::this_grid();
    const int G = gridDim.x;
    LAS unsigned char* xl = lds + RING_BYTES;
    volatile LAS unsigned* bst = (volatile LAS unsigned*)(lds + LDS_BYTES - 16);
    const int wv_ = __builtin_amdgcn_readfirstlane(threadIdx.x >> 6);
    if (threadIdx.x < 4) bst[threadIdx.x] = 0u;
    __syncthreads();
    XcdBarrier xbar; xbar.bar = (unsigned*)args.ws; xbar.x = 0; xbar.st = bst;

    for (int ph = args.ph_lo; ph < args.ph_hi; ++ph) {
#define PH_IDS() const int tid = tid_of(wv_); const int lane = tid & 63, wave = wv_; (void)lane; (void)wave
        int c = blockIdx.x; asm volatile("" : "+s"(c));
        Args A = args; { size_t z_ = 0; asm volatile("" : "+s"(z_)); A.ws = args.ws + z_; A.out = args.out + z_; }
        unsigned char* ws = A.ws;
        bf16_t* HB = (bf16_t*)(ws + WS_HB); float* RS = (float*)(ws + WS_RS);
        if (ph == 0) { PH_IDS(); if (blockIdx.x == 0) { for (int i = tid; i < 16384; i += NTHREADS) ((unsigned*)args.ws)[i] = 0u; }
            if (PHON(0)) prologue_phase(A, lds, tid, wave, lane); }
        else {
            const int l = (ph - 1) / 9, si_ = (ph - 1) % 9, sp = si_ < 6 ? si_ : si_ + 1;
            unsigned char* wl = ws + WS_W + (size_t)l * WL_STRIDE;
            const int nrep = ((REPEAT_MASK >> sp) & 1) ? 2 : 1;
#pragma unroll 1
            for (int rep = 0; rep < nrep; ++rep) {
            if (rep) grid.sync();
            int nplain = 0;
            if (sp == 0) {
                pg8::Gemm g{HB, (const bf16_t*)(wl + W_INA), 1024, 1024, 1024}; pg8::GenOrder S; S.kind = 0; S.t.init(T_, 2048, 1024, 1024, G, c);
                pg8::EpiG1 E{(bf16_t*)(ws + WS_QB), (bf16_t*)(ws + WS_KP), (float*)(ws + WS_GATES), (bf16_t*)(ws + WS_YG), (bf16_t*)(ws + WS_XR), RS, (bf16_t*)(ws + WS_KF)};
                { PH_IDS(); if (PHON(1)) pg8::gemm_phase<false>(lds, xl, g, S, E, tid); }
                nplain = 1;
            } else if (sp == 1) { PH_IDS();
                if (PHON(2)) { int rnd = 0, it = c; do { lru_item_1p(A, l, it >> 7, (G == 256 && (rnd & 1)) ? 127 - (it & 127) : (it & 127), lds, wave); it += G; ++rnd; } while (it < 512); }
                __syncthreads();
                if (PHON(8)) for (int it = c; it < 128; it += G) compress_item(A, l, it, lds, wave);
                __syncthreads();
                nplain = (l == 0) ? 4 : 0;
            } else if (sp == 2) { PH_IDS();
#ifndef LRU2_REP
#define LRU2_REP 1
#endif
#ifndef NSA_REP
#define NSA_REP 1
#endif
#ifndef NSA_VARIANT
#define NSA_VARIANT 0
#endif
                if (wave >= 4) __builtin_amdgcn_s_setprio(1);
                if (PHON(4)) nsa_lut(A, lds, tid);
                if (NSA_REP > 1) for (int pr = c; pr < 256; pr += G) { const int b = pr >> 6, p = pr & 63; nsa_item<NSA_VARIANT>(A, l, b, 127 - p, lds, wave); nsa_item<NSA_VARIANT>(A, l, b, p, lds, wave); }
                if (PHON(4)) for (int pr = c; pr < 256; pr += G) { const int b = (G == 256) ? (pr & 7) >> 1 : pr >> 6, p = (G == 256) ? ((pr & 1) << 5) + (pr >> 3) : pr & 63;
                    nsa_item<0>(A, l, b, 127 - p, lds, wave); nsa_item<0>(A, l, b, p, lds, wave); }
                __builtin_amdgcn_s_setprio(0);
            } else if (sp == 3 || sp == 7) {
                pg8::Gemm g; pg8::ResidOrder S; S.kind = (G == 256) ? 0 : 3; pg8::EpiResid E; E.XB = HB; E.SL = (unsigned long long*)(ws + WS_SLOT); E.RS4 = RS; E.out_f32 = nullptr; E.eps = EPS_;
                if (sp == 3) { g = pg8::Gemm{(const bf16_t*)(ws + WS_AB), (const bf16_t*)(wl + W_OUT), 1024, 1024, 1024}; E.gpost = A.in[I_LN_MIX_POST] + l * D_; E.tag = 1u + 3u * l; }
                else { g = pg8::Gemm{(const bf16_t*)(ws + WS_CO), (const bf16_t*)(wl + W_XO), 1024, 1024, 1024}; E.gpost = A.in[I_LN_X_POST] + l * D_; E.tag = 2u + 3u * l; }
                S.t.init(T_, 1024, g.lda, g.ldb, G, c);
                PH_IDS(); if (PHON(5)) pg8::gemm_phase<false>(lds, xl, g, S, E, tid);
            } else if (sp == 9) {
                pg8::Gemm g{(const bf16_t*)(ws + WS_U), (const bf16_t*)(wl + W_2), FF_ / 2, FF_ / 2, FF_ / 2}; pg8::ResidOrder S; S.kind = (G == 256) ? 0 : 3;
                pg8::EpiResid E; E.XB = HB; E.SL = (unsigned long long*)(ws + WS_SLOT); E.RS4 = RS; E.out_f32 = (l + 1 == NL_) ? A.out : nullptr; E.gpost = A.in[I_LN_MLP_POST] + l * D_; E.tag = 3u + 3u * l;
                E.eps = EPS_ * (U8_SCALE * W8_SCALE) * (U8_SCALE * W8_SCALE);
                S.t.init(T_, 1024, g.lda, g.ldb, G, c);
                PH_IDS(); if (PHON(5)) pg8::gemm_phase<true>(lds, xl, g, S, E, tid);
            } else if (sp == 5) {
                pg8::Gemm g{(const bf16_t*)(ws + WS_CQ), (const bf16_t*)(ws + WS_CK) + (size_t)l * 1024 * 1024, 1024, 1024, 256}; pg8::GenOrder S; S.kind = 4; S.t.init(T_, 1024, 1024, 1024, G, c);
                pg8::EpiSoftmax E{(bf16_t*)(ws + WS_PP)}; PH_IDS(); if (PHON(6)) pg8::gemm_phase<false>(lds, xl, g, S, E, tid);
                nplain = 1;
            } else nplain = 1;
#pragma unroll 1
            for (int q = 0; q < nplain; ++q) {
                pg8::Gemm g; pg8::GenOrder S; S.kind = 0; pg8::EpiBf16 E; E.row_limit = 1 << 30; E.act = 0; E.rs = RS; E.rs_mode = 0; E.vf = nullptr;
                if (sp == 0 && q == 0) { g = pg8::Gemm{(const bf16_t*)(wl + W_INV), HB, 1024, 1024, 1024}; S.t.init(512, T_, 1024, 1024, G, c); E.O = (bf16_t*)(ws + WS_VT); E.ldc = T_; E.row_limit = 384; E.rs_mode = 2; E.vf = (bf16_t*)(ws + WS_VF); }
                else if (sp == 1) { const int ll = q >> 1; unsigned char* w2 = ws + WS_W + (size_t)ll * WL_STRIDE; S.t.init(1024, 1024, 1024, 1024, G, (c + 4 * G - 128 - 16 * q) % G); E.ldc = 1024;
                    if ((q & 1) == 0) { g = pg8::Gemm{(const bf16_t*)(ws + WS_MNB), (const bf16_t*)(w2 + W_XK), 1024, 1024, 1024}; E.O = (bf16_t*)(ws + WS_CK) + (size_t)ll * 1024 * 1024; }
                    else { g = pg8::Gemm{(const bf16_t*)(w2 + W_XV), (const bf16_t*)(ws + WS_MNB), 1024, 1024, 1024}; E.O = (bf16_t*)(ws + WS_CVT) + (size_t)ll * 1024 * 1024; } }
                else if (sp == 4) { g = pg8::Gemm{HB, (const bf16_t*)(wl + W_XQ), 1024, 1024, 1024}; S.t.init(T_, 1024, 1024, 1024, G, c); E.O = (bf16_t*)(ws + WS_CQ); E.ldc = 1024; E.rs_mode = 1; }
                else if (sp == 5) { g = pg8::Gemm{(const bf16_t*)(ws + WS_PP), (const bf16_t*)(ws + WS_CVT) + (size_t)l * 1024 * 1024, 1024, 1024, 256}; S.kind = 5; S.t.init(T_, 1024, 1024, 1024, G, c); E.O = (bf16_t*)(ws + WS_CO); E.ldc = 1024; }
                else { g = pg8::Gemm{HB, (const bf16_t*)(wl + W_1), 1024, 1024, 1024}; S.t.init(T_, FF_, 1024, 1024, G, c); E.O = (bf16_t*)(ws + WS_U); E.ldc = FF_; E.act = 2; E.rs_mode = 1; }
                PH_IDS(); if (PHON(7)) pg8::gemm_phase<false>(lds, xl, g, S, E, tid);
            }
            }
        }
        const bool local_seam = ph > 0 && ((ph - 1) % 9) == 4;
        if (ph + 1 < args.ph_hi && !local_seam) { const bool leader = tid_of(wv_) == 0; if (ph == 0) { grid.sync(); xbar = xcd_barrier_post((unsigned*)args.ws, bst, leader); } else xcd_barrier(xbar, leader); }
    }
}

#ifndef N_LAUNCH_MODE
#define N_LAUNCH_MODE 1
#endif
extern "C" void kernel_launch(void* const* d_in, const int* in_sizes, int n_in, void* d_out, int out_size, void* d_ws, size_t ws_size, hipStream_t stream) {
    static int grid = 0;
    if (grid == 0) {
        if (n_in != 30 || out_size != T_ * D_ || ws_size < WS_END) { fprintf(stderr, "kernel_launch: unexpected problem (n_in %d, out %d, ws %zu)\n", n_in, out_size, ws_size); grid = -1; return; }
        int dev = 0, cus = 0, per_cu = 0;
        (void)hipGetDevice(&dev); (void)hipDeviceGetAttribute(&cus, hipDeviceAttributeMultiprocessorCount, dev);
        if (hipFuncSetAttribute((const void*)trunk_fwd, hipFuncAttributeMaxDynamicSharedMemorySize, LDS_BYTES) != hipSuccess) { fprintf(stderr, "kernel_launch: hipFuncSetAttribute failed\n"); grid = -1; return; }
        if (hipOccupancyMaxActiveBlocksPerMultiprocessor(&per_cu, (const void*)trunk_fwd, NTHREADS, LDS_BYTES) != hipSuccess || per_cu < 1) { fprintf(stderr, "kernel_launch: occupancy query says %d\n", per_cu); per_cu = 1; }
        (void)hipGetLastError();
        grid = cus;
        if (grid > 256) grid = 256;
        if (grid != 256) grid &= ~3;
    }
    if (grid < 0) return;
    Args a{};
    for (int i = 0; i < 30; ++i) a.in[i] = (const float*)d_in[i];
    a.out = (float*)d_out; a.ws = (unsigned char*)d_ws;
#if N_LAUNCH_MODE == 1
    a.ph_lo = 0; a.ph_hi = NPH;
    { void* kargs[] = {&a};
      hipError_t e = hipLaunchCooperativeKernel((const void*)trunk_fwd, dim3(grid), dim3(NTHREADS), kargs, LDS_BYTES, stream);
      if (e != hipSuccess) fprintf(stderr, "kernel_launch: cooperative launch failed: %s (grid %d)\n", hipGetErrorString(e), grid); }
#else
    for (int ph = 0; ph < NPH; ++ph) { a.ph_lo = ph; a.ph_hi = ph + 1; void* kargs[] = {&a};
        hipError_t e = hipLaunchCooperativeKernel((const void*)trunk_fwd, dim3(grid), dim3(NTHREADS), kargs, LDS_BYTES, stream);
        if (e != hipSuccess) { fprintf(stderr, "kernel_launch: cooperative launch %d failed: %s (grid %d)\n", ph, hipGetErrorString(e), grid); break; } }
#endif
}
```

```cpp
#include <hip/hip_runtime.h>
#include <hip/hip_cooperative_groups.h>
#include <cstdio>
#include <cstdint>
namespace cg = cooperative_groups;

#define LAS __attribute__((address_space(3)))
typedef unsigned short bf16_t;
typedef short bf16x8 __attribute__((ext_vector_type(8)));
typedef short s16x4 __attribute__((ext_vector_type(4)));
typedef float f32x2 __attribute__((ext_vector_type(2)));
typedef float f32x4 __attribute__((ext_vector_type(4)));
typedef float f32x16 __attribute__((ext_vector_type(16)));
typedef unsigned u32x2 __attribute__((ext_vector_type(2)));
typedef unsigned u32x4 __attribute__((ext_vector_type(4)));
typedef int i32x4 __attribute__((ext_vector_type(4)));
typedef int i32x8 __attribute__((ext_vector_type(8)));

constexpr int NB_ = 4, S_ = 8192, T_ = NB_ * S_, D_ = 1024, NL_ = 2, FF_ = 4096, MEM_ = 256;
constexpr int INC_ = 2328;
constexpr float EPS_ = 1e-6f, NEG_ = -1e30f, LOG2E_ = 1.4426950408889634f;
constexpr float C2_ = 0.125f * LOG2E_, XC2_ = 0.0625f * LOG2E_;

constexpr size_t MiB = 1u << 20;
constexpr size_t WS_PEP = 1 * MiB;
constexpr size_t WS_W = 2 * MiB, WL_STRIDE = 33 * MiB;
constexpr size_t W_INA = 0, W_INV = 4 * MiB, W_OUT = 5 * MiB, W_XQ = 7 * MiB, W_XK = 9 * MiB, W_XV = 11 * MiB, W_XO = 13 * MiB,
                 W_1 = 15 * MiB, W_2 = 23 * MiB, W_CK = 31 * MiB, W_CV = 31 * MiB + 512 * 1024, W_A = 32 * MiB, W_X = 32 * MiB + 65536;
constexpr size_t WS_MNB = 68 * MiB;
constexpr size_t WS_CK = 70 * MiB;
constexpr size_t WS_CVT = 74 * MiB;
constexpr size_t WS_KCB = 78 * MiB;
constexpr size_t WS_VCT = 79 * MiB;
constexpr size_t WS_AGG = 80 * MiB;
constexpr size_t WS_RS = 82 * MiB;
constexpr size_t WS_HB = 84 * MiB;
constexpr size_t WS_SLOT = 148 * MiB;
constexpr size_t WS_AGG2 = 150 * MiB;
constexpr size_t WS_U = 212 * MiB;
constexpr size_t WS_QB = WS_U;
constexpr size_t WS_KP = WS_U + 32 * MiB;
constexpr size_t WS_VT = WS_U + 56 * MiB;
constexpr size_t WS_GATES = WS_U + 88 * MiB;
constexpr size_t WS_YG = WS_U + 92 * MiB;
constexpr size_t WS_XR = WS_U + 124 * MiB;
constexpr size_t WS_AB = WS_U + 156 * MiB;
constexpr size_t WS_KF = WS_U + 220 * MiB;
constexpr size_t WS_VF = WS_U + 228 * MiB;
constexpr size_t WS_CQ = WS_U;
constexpr size_t WS_PP = WS_U + 64 * MiB;
constexpr size_t WS_CO = WS_U + 128 * MiB;
constexpr size_t WS_END = WS_U + 256 * MiB;

constexpr float U8_SCALE = 8.0f  , W8_SCALE = 1024.0f;
constexpr int LDS_BYTES = 147456;
constexpr int RING_BYTES = 131072;
constexpr int NTHREADS = 512;

__device__ __forceinline__ unsigned f2bf(float f) { unsigned u = __builtin_bit_cast(unsigned, f); return (u + 0x7fffu + ((u >> 16) & 1u)) >> 16; }
typedef __bf16 bf16x2n __attribute__((ext_vector_type(2)));
__device__ __forceinline__ unsigned pk2(float lo, float hi) { return __builtin_bit_cast(unsigned, __builtin_convertvector((f32x2){lo, hi}, bf16x2n)); }
__device__ __forceinline__ unsigned cvt_pk_bf16(float lo, float hi) { return __builtin_bit_cast(unsigned, __builtin_convertvector((f32x2){lo, hi}, bf16x2n)); }
__device__ __forceinline__ float bflo(unsigned w) { return __builtin_bit_cast(float, w << 16); }
__device__ __forceinline__ float bfhi(unsigned w) { return __builtin_bit_cast(float, w & 0xffff0000u); }
__device__ __forceinline__ float bf2f(bf16_t h) { return __builtin_bit_cast(float, (unsigned)h << 16); }
__device__ __forceinline__ float ex2(float x) { return __builtin_amdgcn_exp2f(x); }
__device__ __forceinline__ float rcp(float x) { return __builtin_amdgcn_rcpf(x); }
__device__ __forceinline__ float sigmoidf_(float x) { return rcp(1.0f + ex2(-LOG2E_ * x)); }
__device__ __forceinline__ float gelu_tanh(float x) { const float z = x + 0.044715f * x * x * x; return x * rcp(1.0f + ex2(-2.302208198f * z)); }
__device__ __forceinline__ float rs_of(f32x4 p) { return __builtin_amdgcn_rsqf(((p.x + p.y) + (p.z + p.w)) * (1.f / D_) + EPS_); }
__device__ __forceinline__ int crow(int r, int hi) { return (r & 3) + 8 * (r >> 2) + 4 * hi; }
__device__ __forceinline__ int lane_v() { int l; asm volatile("v_mbcnt_lo_u32_b32 %0, -1, 0\n\tv_mbcnt_hi_u32_b32 %0, -1, %0" : "=v"(l)); return l; }
__device__ __forceinline__ int tid_of(int wave) { return (wave << 6) | lane_v(); }
__device__ __forceinline__ float sum32(float v) { const auto r = __builtin_amdgcn_permlane32_swap(__float_as_uint(v), __float_as_uint(v), false, false); return __uint_as_float(r[0]) + __uint_as_float(r[1]); }
__device__ __forceinline__ float max32(float v) { const auto r = __builtin_amdgcn_permlane32_swap(__float_as_uint(v), __float_as_uint(v), false, false); return fmaxf(__uint_as_float(r[0]), __uint_as_float(r[1])); }
__device__ __forceinline__ float sum16(float v) { const auto r = __builtin_amdgcn_permlane16_swap(__float_as_uint(v), __float_as_uint(v), false, false); return __uint_as_float(r[0]) + __uint_as_float(r[1]); }
__device__ __forceinline__ float max16(float v) { const auto r = __builtin_amdgcn_permlane16_swap(__float_as_uint(v), __float_as_uint(v), false, false); return fmaxf(__uint_as_float(r[0]), __uint_as_float(r[1])); }
__device__ __forceinline__ float shx(float v, int m) { return __int_as_float(__builtin_amdgcn_ds_bpermute((lane_v() ^ m) << 2, __float_as_int(v))); }
__device__ __forceinline__ int shup8(int v, int d) { const int s = lane_v(); return __builtin_amdgcn_ds_bpermute((((s & 7) >= d) ? s - d : s) << 2, v); }
__device__ __forceinline__ float wave_sum(float v) {
    const int l_ = lane_v();
#pragma unroll
    for (int o = 1; o < 64; o <<= 1) v += __int_as_float(__builtin_amdgcn_ds_bpermute((l_ ^ o) << 2, __float_as_int(v)));
    return v;
}
#define LDS_WAIT() asm volatile("s_waitcnt lgkmcnt(0)" ::: "memory")
#define VM_WAIT() asm volatile("s_waitcnt vmcnt(0)" ::: "memory")

namespace pg8 {
constexpr int BM = 256, BK = 64, HALF = 128, HTB = HALF * BK * 2, STAGE_BYTES = 8 * HTB, NXCD = 8, WGM = 8;
__device__ __forceinline__ int lds_byte(int r, int c) { const int st = (r >> 4) * 2 + (c >> 5), rr = r & 15, cc = c & 31, ob = rr * 64 + cc * 2; return st * 1024 + (ob ^ (((ob >> 9) & 1) << 5)); }
__device__ __forceinline__ void stage_rc(int b, int& R, int& C) { const int st = b / 1024, sb = b % 1024, swz = sb ^ (((sb >> 9) & 1) << 5); R = (st >> 1) * 16 + swz / 64; C = (st & 1) * 32 + (swz % 64) / 2; }
__device__ __forceinline__ int perm32(int rho) { const int n = rho >> 4, i = rho & 15; return 8 * (i >> 2) + 4 * n + (i & 3); }

struct Unit { int pm, pn; long aoff, boff; };
struct Gemm { const bf16_t* A; const bf16_t* Bt; int lda, ldb, K; };

struct TileOrder {
    int nM, nN, nwg, G, c; long astep, bstep;
    __device__ void init(int M, int N, int lda, int ldb, int G_, int c_) { nM = M / BM; nN = N / BM; nwg = nM * nN; G = G_; c = c_; astep = (long)BM * lda * 2; bstep = (long)BM * ldb * 2; }
    __device__ bool next(int i, Unit& u) const {
        const long L = (long)i * G + c; if (L >= nwg) return false;
        int wgid = (int)L; { const int q = nwg / NXCD, r = nwg % NXCD, xcd = wgid % NXCD, off = wgid / NXCD; wgid = (xcd < r ? xcd * (q + 1) : r * (q + 1) + (xcd - r) * q) + off; }
        const int nig = WGM * nN, gid = wgid / nig, fm = gid * WGM, gsz = (nM - fm) < WGM ? (nM - fm) : WGM;
        u.pm = fm + ((wgid % nig) % gsz); u.pn = (wgid % nig) / gsz; u.aoff = u.pm * astep; u.boff = u.pn * bstep; return true;
    }
};
struct ResidOrder {
    int kind; TileOrder t;
    __device__ bool next(int i, Unit& u) const {
        if (kind == 0) return t.next(i, u);
        const long L = (long)i * t.G + t.c; if (L >= 512) return false;
        u.pm = (int)L >> 2; u.pn = (int)L & 3; u.aoff = u.pm * t.astep; u.boff = u.pn * t.bstep; return true;
    }
};
struct GenOrder {
    int kind; TileOrder t;
    __device__ bool next(int i, Unit& u) const {
        if (kind == 0) return t.next(i, u);
        if (kind >= 4) { if (!t.next(i, u)) return false;
            const int h = u.pn, pmg = u.pm, b = pmg >> 5; u.aoff = ((long)pmg * 256 * 1024 + h * 256) * 2;
            u.boff = kind == 4 ? ((long)b * 256 * 1024 + h * 256) * 2 : ((long)h * 256 * 1024 + b * 256) * 2; return true; }
        const long L = (long)i * t.G + t.c; if (L >= 512) return false;
        const int h = (int)L & 3, pmg = (int)L >> 2, b = pmg >> 5;
        u.pm = pmg; u.pn = h; u.aoff = ((long)pmg * 256 * 1024 + h * 256) * 2;
        u.boff = kind == 1 ? ((long)b * 256 * 1024 + h * 256) * 2 : ((long)h * 256 * 1024 + b * 256) * 2; return true;
    }
};

struct EpiBf16 {
    static constexpr bool NEEDS_LDS = false, RS_PREFETCH = true;
    bf16_t* O; long ldc; int row_limit; int act; const float* rs; int rs_mode; bf16_t* vf;
    __device__ __forceinline__ void operator()(f32x4 (&acc)[2][2][4][2], const Unit& u, int wr, int wc, int fr, int fq, LAS unsigned char* xl) const {
        asm volatile("" : "+v"(fr), "+v"(fq));
        const int row0 = u.pm * BM + wr * 64 + fr; const int col0 = u.pn * BM + wc * 32 + 8 * fq;
        float rs8[2][4];
#pragma unroll
        for (int ai = 0; ai < 2; ++ai)
#pragma unroll
            for (int m = 0; m < 4; ++m) rs8[ai][m] = rs_mode == 1 ? rs_of(*(const LAS f32x4*)(xl + (wr * 64 + fr + ai * HALF + m * 16) * 16)) : 1.0f;
        if (act == 2) {
            const int odd = fq & 1;
            unsigned char* lane0 = (unsigned char*)O + (size_t)(row0 + odd * 16) * ldc + col0 - odd * 8;
#pragma unroll
            for (int ai = 0; ai < 2; ++ai)
#pragma unroll
                for (int mp = 0; mp < 2; ++mp)
#pragma unroll
                    for (int bj = 0; bj < 2; ++bj) { unsigned pq[2][2];
#pragma unroll
                        for (int k = 0; k < 2; ++k) { const int m = 2 * mp + k; const float r2 = rs8[ai][m] * 2.8284271f; f32x4 z0 = acc[ai][bj][m][0] * r2, z1 = acc[ai][bj][m][1] * r2;
#pragma unroll
                            for (int e = 0; e < 4; ++e) { z0[e] = __builtin_amdgcn_fmed3f(z0[e], 0.f, 21.16f); z1[e] = __builtin_amdgcn_fmed3f(z1[e], 0.f, 21.16f); }
                            z0 *= z0; z1 *= z1;
                            int p0 = __builtin_amdgcn_cvt_pk_fp8_f32(z0[0], z0[1], 0, false); p0 = __builtin_amdgcn_cvt_pk_fp8_f32(z0[2], z0[3], p0, true);
                            int p1 = __builtin_amdgcn_cvt_pk_fp8_f32(z1[0], z1[1], 0, false); p1 = __builtin_amdgcn_cvt_pk_fp8_f32(z1[2], z1[3], p1, true);
                            pq[k][0] = (unsigned)p0; pq[k][1] = (unsigned)p1; }
                        const auto s0 = __builtin_amdgcn_permlane16_swap(pq[0][0], pq[1][0], false, false), s1 = __builtin_amdgcn_permlane16_swap(pq[0][1], pq[1][1], false, false);
                        *(u32x4*)(lane0 + (size_t)(ai * HALF + mp * 32) * ldc + bj * HALF) = (u32x4){s0[0], s1[0], s0[1], s1[1]}; }
            return; }
        if (act == 0 && rs_mode != 2 && vf == nullptr && row_limit >= (1 << 30)) {
#pragma unroll
            for (int ai = 0; ai < 2; ++ai)
#pragma unroll
                for (int m = 0; m < 4; ++m) { const float rsr = rs8[ai][m]; bf16_t* rowp = O + (size_t)(row0 + ai * HALF + m * 16) * ldc + col0;
#pragma unroll
                    for (int bj = 0; bj < 2; ++bj) { const f32x4 v0 = acc[ai][bj][m][0] * rsr, v1 = acc[ai][bj][m][1] * rsr;
                        u32x4 w; w.x = cvt_pk_bf16(v0[0], v0[1]); w.y = cvt_pk_bf16(v0[2], v0[3]); w.z = cvt_pk_bf16(v1[0], v1[1]); w.w = cvt_pk_bf16(v1[2], v1[3]);
                        *(u32x4*)(rowp + bj * HALF) = w; } }
            return; }
#pragma unroll
        for (int bj = 0; bj < 2; ++bj) { f32x4 cs0 = (f32x4){1.f, 1.f, 1.f, 1.f}, cs1 = cs0;
            if (rs_mode == 2) {
#pragma unroll
                for (int e = 0; e < 4; ++e) { cs0[e] = rs_of(((const f32x4*)rs)[col0 + bj * HALF + e]); cs1[e] = rs_of(((const f32x4*)rs)[col0 + bj * HALF + 4 + e]); } }
#pragma unroll
            for (int ai = 0; ai < 2; ++ai)
#pragma unroll
                for (int m = 0; m < 4; ++m) { const int row = row0 + ai * HALF + m * 16; if (row >= row_limit) continue; bf16_t* rowp = O + (size_t)row * ldc + col0;
                    const float rsr = rs8[ai][m];
                    f32x4 v0 = acc[ai][bj][m][0] * rsr, v1 = acc[ai][bj][m][1] * rsr;
                    if (rs_mode == 2) { v0 *= cs0; v1 *= cs1; }
                    if (act >= 1) {
#pragma unroll
                        for (int e = 0; e < 4; ++e) { const float a = fmaxf(v0[e], 0.f), b = fmaxf(v1[e], 0.f); v0[e] = a * a; v1[e] = b * b; } }
                    u32x4 w; w.x = cvt_pk_bf16(v0[0], v0[1]); w.y = cvt_pk_bf16(v0[2], v0[3]); w.z = cvt_pk_bf16(v1[0], v1[1]); w.w = cvt_pk_bf16(v1[2], v1[3]);
                    *(u32x4*)(rowp + bj * HALF) = w;
                    if (vf && row >= 128 && row < 256) { const int g = (row >> 6) & 1, d = row & 63, col = col0 + bj * HALF, k0 = col & 63;
                        bf16_t* p = vf + ((size_t)g * (T_ / 64) + (col >> 6)) * 4096 + (((((k0 >> 5) * 2 + ((k0 >> 4) & 1)) * 2 + (d >> 5)) * 2) * 32 + (d & 31)) * 8 + 4 * ((k0 >> 3) & 1);
                        const auto s0 = __builtin_amdgcn_permlane16_swap(w.x, w.z, false, false), s1 = __builtin_amdgcn_permlane16_swap(w.y, w.w, false, false);
                        *(u32x4*)(p + ((fq & 1) ? 252 : 0)) = (u32x4){s0[0], s1[0], s0[1], s1[1]}; } } }
    }
};
struct EpiG1 {
    static constexpr bool NEEDS_LDS = false, RS_PREFETCH = true;
    bf16_t* QB; bf16_t* KP; float* GATES; bf16_t* YG; bf16_t* XR; const float* rs; bf16_t* KF;
    __device__ __forceinline__ void operator()(f32x4 (&acc)[2][2][4][2], const Unit& u, int wr, int wc, int fr, int fq, LAS unsigned char* xl) const {
        asm volatile("" : "+v"(fr), "+v"(fq));
        const int row0 = u.pm * BM + wr * 64 + fr; const int pn = u.pn; const int cl0 = wc * 32 + 8 * fq;
        float rs8[2][4];
#pragma unroll
        for (int ai = 0; ai < 2; ++ai)
#pragma unroll
            for (int m = 0; m < 4; ++m) rs8[ai][m] = rs_of(*(const LAS f32x4*)(xl + (wr * 64 + fr + ai * HALF + m * 16) * 16));
#pragma unroll
        for (int ai = 0; ai < 2; ++ai)
#pragma unroll
            for (int m = 0; m < 4; ++m) { const size_t row = (size_t)(row0 + ai * HALF + m * 16); const float rsr = rs8[ai][m];
#pragma unroll
                for (int bj = 0; bj < 2; ++bj) { f32x4 v0 = acc[ai][bj][m][0] * rsr, v1 = acc[ai][bj][m][1] * rsr;
                    bf16_t* dst = nullptr;
                    if (pn < 2) dst = QB + row * 512 + pn * 256 + bj * 128 + cl0;
                    else if (pn == 2 || (pn == 3 && bj == 0)) { const int plane = (pn == 2) ? bj : 2; const int g = cl0 >> 6, d = cl0 & 63; dst = KP + ((size_t)(plane * 2 + g) * T_ + row) * 64 + d; }
                    else if (pn == 3) {
                        if (cl0 < 24) { float* gp = GATES + row * 24 + cl0; f32x4 a, b;
#pragma unroll
                            for (int e = 0; e < 4; ++e) { a[e] = sigmoidf_(v0[e]); b[e] = sigmoidf_(v1[e]); }
                            *(f32x4*)gp = a; *(f32x4*)(gp + 4) = b; }
                        continue; }
                    else if (pn < 6) { dst = YG + row * 512 + (pn - 4) * 256 + bj * 128 + cl0;
#pragma unroll
                        for (int e = 0; e < 4; ++e) { v0[e] = gelu_tanh(v0[e]); v1[e] = gelu_tanh(v1[e]); } }
                    else dst = XR + row * 512 + (pn - 6) * 256 + bj * 128 + cl0;
                    u32x4 w; w.x = cvt_pk_bf16(v0[0], v0[1]); w.y = cvt_pk_bf16(v0[2], v0[3]); w.z = cvt_pk_bf16(v1[0], v1[1]); w.w = cvt_pk_bf16(v1[2], v1[3]);
                    *(u32x4*)dst = w;
                    if (pn == 2 && bj == 1) { const int g = cl0 >> 6, d = cl0 & 63, key = (int)row & 63;
                        *(u32x4*)(KF + ((size_t)g * (T_ / 64) + (row >> 6)) * 4096 + ((((key >> 5) * 4 + (d >> 4)) * 2 + ((d >> 3) & 1)) * 32 + (key & 31)) * 8) = w; } } }
    }
};
struct EpiSoftmax {
    static constexpr bool NEEDS_LDS = true, RS_PREFETCH = false;
    bf16_t* P;
    __device__ __forceinline__ void operator()(f32x4 (&acc)[2][2][4][2], const Unit& u, int wr, int wc, int fr, int fq, LAS unsigned char* xl) const {
        asm volatile("" : "+v"(fr), "+v"(fq));
        LAS f32x2* X = (LAS f32x2*)xl;
#pragma unroll
        for (int ai = 0; ai < 2; ++ai)
#pragma unroll
            for (int m = 0; m < 4; ++m) { float mx = NEG_;
#pragma unroll
                for (int bj = 0; bj < 2; ++bj)
#pragma unroll
                    for (int n = 0; n < 2; ++n)
#pragma unroll
                        for (int e = 0; e < 4; ++e) mx = fmaxf(mx, acc[ai][bj][m][n][e]);
                mx = max16(max32(mx));
                float s = 0.f;
#pragma unroll
                for (int bj = 0; bj < 2; ++bj)
#pragma unroll
                    for (int n = 0; n < 2; ++n)
#pragma unroll
                        for (int e = 0; e < 4; ++e) { const float p = ex2(acc[ai][bj][m][n][e] - mx); acc[ai][bj][m][n][e] = p; s += p; }
                s = sum16(sum32(s));
                X[(ai * HALF + wr * 64 + m * 16 + fr) * 4 + wc] = (f32x2){mx, s}; }
        LDS_WAIT(); __builtin_amdgcn_s_barrier(); asm volatile("" ::: "memory");
        const size_t row0 = (size_t)u.pm * BM + wr * 64 + fr; const int col0 = u.pn * BM + wc * 32 + 8 * fq;
#pragma unroll
        for (int ai = 0; ai < 2; ++ai)
#pragma unroll
            for (int m = 0; m < 4; ++m) { const int r = ai * HALF + wr * 64 + m * 16 + fr;
                asm volatile("" ::: "memory");
                const f32x2 a = X[r * 4 + 0], b = X[r * 4 + 1], c = X[r * 4 + 2], d = X[r * 4 + 3];
                const float M = fmaxf(fmaxf(a.x, b.x), fmaxf(c.x, d.x));
                const float Lsum = a.y * ex2(a.x - M) + b.y * ex2(b.x - M) + c.y * ex2(c.x - M) + d.y * ex2(d.x - M);
                const float mine = wc == 0 ? a.x : (wc == 1 ? b.x : (wc == 2 ? c.x : d.x));
                const float f = ex2(mine - M) * rcp(Lsum);
                bf16_t* rowp = P + (row0 + ai * HALF + m * 16) * 1024 + col0;
#pragma unroll
                for (int bj = 0; bj < 2; ++bj) { const f32x4 v0 = acc[ai][bj][m][0] * f, v1 = acc[ai][bj][m][1] * f;
                    u32x4 w; w.x = cvt_pk_bf16(v0[0], v0[1]); w.y = cvt_pk_bf16(v0[2], v0[3]); w.z = cvt_pk_bf16(v1[0], v1[1]); w.w = cvt_pk_bf16(v1[2], v1[3]);
                    *(u32x4*)(rowp + bj * HALF) = w; } }
        LDS_WAIT();
    }
};

struct EpiResid {
    static constexpr bool NEEDS_LDS = true, RS_PREFETCH = false;
    bf16_t* XB; const float* gpost; unsigned long long* SL; float* RS4; float* out_f32; unsigned tag; float eps;
    __device__ __forceinline__ static void reduce8(const float (&s)[8], float (&d)[2]) {
        float c[4];
#pragma unroll
        for (int j = 0; j < 4; ++j) { const auto r = __builtin_amdgcn_permlane32_swap(__float_as_uint(s[2 * j]), __float_as_uint(s[2 * j + 1]), false, false);
            c[j] = __uint_as_float(r[0]) + __uint_as_float(r[1]); }
#pragma unroll
        for (int k = 0; k < 2; ++k) { const auto r = __builtin_amdgcn_permlane16_swap(__float_as_uint(c[2 * k]), __float_as_uint(c[2 * k + 1]), false, false);
            d[k] = __uint_as_float(r[0]) + __uint_as_float(r[1]); }
    }
    __device__ __forceinline__ void operator()(f32x4 (&acc)[2][2][4][2], const Unit& u, int wr, int wc, int, int, LAS unsigned char* xl) const {
        const int tid_ = tid_of(wr * 4 + wc); const int fr = tid_ & 15, fq = (tid_ >> 4) & 3;
        LAS float* X = (LAS float*)xl; LAS float* RY = (LAS float*)(xl + 4096);
        const int lrow0 = wr * 64 + fr, t = wc * 64 + fq * 16 + fr;
        const int xoff = (lrow0 + (((fq & 1) << 1) | (fq >> 1)) * 16) * 4 + wc;
        { float s[8], d[2];
#pragma unroll
          for (int ai = 0; ai < 2; ++ai)
#pragma unroll
            for (int m = 0; m < 4; ++m) { float a = 0.f;
#pragma unroll
                for (int bj = 0; bj < 2; ++bj)
#pragma unroll
                    for (int n = 0; n < 2; ++n)
#pragma unroll
                        for (int e = 0; e < 4; ++e) a = fmaf(acc[ai][bj][m][n][e], acc[ai][bj][m][n][e], a);
                s[ai * 4 + m] = a; }
          reduce8(s, d); X[xoff] = d[0]; X[HALF * 4 + xoff] = d[1]; }
        LDS_WAIT(); __builtin_amdgcn_s_barrier(); asm volatile("" ::: "memory");
        unsigned long long* sl = SL + (size_t)u.pm * 1024 + t;
        if (wr == 0) { const f32x4 v = *(const LAS f32x4*)(X + t * 4); const float s = (v.x + v.y) + (v.z + v.w);
            __hip_atomic_store(sl + u.pn * 256, ((unsigned long long)tag << 32) | (unsigned long long)__builtin_bit_cast(unsigned, s), __ATOMIC_RELAXED, __HIP_MEMORY_SCOPE_AGENT); }
        const int col0 = u.pn * BM + wc * 32 + 8 * fq;
        const size_t tile0 = ((size_t)u.pm * BM + wr * 64) * D_ + u.pn * BM + wc * 32;
        const unsigned vo = (unsigned)(fr * D_ + 8 * fq);
        char* xt = (char*)(XB + tile0);
        u32x4 xw[2][4][2];
#define RESID_LDX(ai, m0, m1) do { _Pragma("unroll") for (int m = m0; m < m1; ++m) _Pragma("unroll") for (int bj = 0; bj < 2; ++bj) \
            xw[ai][m][bj] = *(const u32x4*)(xt + (size_t)(((ai) * HALF + m * 16) * D_ + bj * HALF) * 2 + vo * 2u); } while (0)
        RESID_LDX(0, 0, 4); RESID_LDX(1, 0, 3);
        if (wr == 0) { unsigned long long v0, v1, v2, v3; unsigned sp = 0;
            for (;;) { v0 = __hip_atomic_load(sl, __ATOMIC_RELAXED, __HIP_MEMORY_SCOPE_AGENT); v1 = __hip_atomic_load(sl + 256, __ATOMIC_RELAXED, __HIP_MEMORY_SCOPE_AGENT);
                v2 = __hip_atomic_load(sl + 512, __ATOMIC_RELAXED, __HIP_MEMORY_SCOPE_AGENT); v3 = __hip_atomic_load(sl + 768, __ATOMIC_RELAXED, __HIP_MEMORY_SCOPE_AGENT);
                if (((unsigned)(v0 >> 32) == tag) & ((unsigned)(v1 >> 32) == tag) & ((unsigned)(v2 >> 32) == tag) & ((unsigned)(v3 >> 32) == tag)) break;
                __builtin_amdgcn_s_sleep(1); if (++sp > (1u << 22)) break; }
            const float s = (__builtin_bit_cast(float, (unsigned)v0) + __builtin_bit_cast(float, (unsigned)v1)) + (__builtin_bit_cast(float, (unsigned)v2) + __builtin_bit_cast(float, (unsigned)v3));
            RY[t] = __builtin_amdgcn_rsqf(s * (1.f / D_) + eps); }
        LDS_WAIT(); __builtin_amdgcn_s_barrier(); asm volatile("" ::: "memory");
        RESID_LDX(1, 3, 4);
#undef RESID_LDX
        f32x4 g[2][2]; float sq[8];
#pragma unroll
        for (int bj = 0; bj < 2; ++bj) { g[bj][0] = *(const f32x4*)(gpost + col0 + bj * HALF); g[bj][1] = *(const f32x4*)(gpost + col0 + bj * HALF + 4); }
#pragma unroll
        for (int ai = 0; ai < 2; ++ai)
#pragma unroll
            for (int m = 0; m < 4; ++m) { const float ry = RY[ai * HALF + lrow0 + m * 16]; float s2 = 0.f;
#pragma unroll
                for (int bj = 0; bj < 2; ++bj) { const u32x4 w = xw[ai][m][bj];
                    f32x4 x0 = (f32x4){bflo(w.x), bfhi(w.x), bflo(w.y), bfhi(w.y)}, x1 = (f32x4){bflo(w.z), bfhi(w.z), bflo(w.w), bfhi(w.w)};
                    x0 = x0 + (acc[ai][bj][m][0] * ry) * g[bj][0]; x1 = x1 + (acc[ai][bj][m][1] * ry) * g[bj][1];
                    if (out_f32) { char* op = (char*)(out_f32 + tile0) + (size_t)((ai * HALF + m * 16) * D_ + bj * HALF) * 4 + vo * 4u; *(f32x4*)op = x0; *(f32x4*)(op + 16) = x1; }
                    else { s2 += ((x0.x * x0.x + x0.y * x0.y) + (x0.z * x0.z + x0.w * x0.w)) + ((x1.x * x1.x + x1.y * x1.y) + (x1.z * x1.z + x1.w * x1.w));
                        u32x4 o; o.x = cvt_pk_bf16(x0[0], x0[1]); o.y = cvt_pk_bf16(x0[2], x0[3]); o.z = cvt_pk_bf16(x1[0], x1[1]); o.w = cvt_pk_bf16(x1[2], x1[3]);
                        *(u32x4*)(xt + (size_t)((ai * HALF + m * 16) * D_ + bj * HALF) * 2 + vo * 2u) = o; } }
                sq[ai * 4 + m] = s2; }
        if (!out_f32) { float d[2]; reduce8(sq, d);
            const int tid2 = tid_of(wr * 4 + wc); const int fr2 = tid2 & 15, fq2 = (tid2 >> 4) & 3, t2 = wc * 64 + (tid2 & 63);
            const int xoff2 = (wr * 64 + fr2 + (((fq2 & 1) << 1) | (fq2 >> 1)) * 16) * 4 + wc;
            X[xoff2] = d[0]; X[HALF * 4 + xoff2] = d[1]; LDS_WAIT(); __builtin_amdgcn_s_barrier(); asm volatile("" ::: "memory");
            if (wr == 0) { const f32x4 v = *(const LAS f32x4*)(X + t2 * 4); RS4[((size_t)u.pm * BM + t2) * 4 + u.pn] = (v.x + v.y) + (v.z + v.w); } }
        LDS_WAIT();
    }
};

template <bool F8>
__device__ __forceinline__ void mma_step(f32x4& c, const bf16x8 (&b)[2], const bf16x8 (&a)[2], int sc) {
    if constexpr (F8) {
        const i32x8 B = __builtin_shufflevector(__builtin_bit_cast(i32x4, b[0]), __builtin_bit_cast(i32x4, b[1]), 0, 1, 2, 3, 4, 5, 6, 7);
        const i32x8 A = __builtin_shufflevector(__builtin_bit_cast(i32x4, a[0]), __builtin_bit_cast(i32x4, a[1]), 0, 1, 2, 3, 4, 5, 6, 7);
        c = __builtin_amdgcn_mfma_scale_f32_16x16x128_f8f6f4(B, A, c, 0, 0, 0, 0, 0, 0); (void)sc;
    } else {
        c = __builtin_amdgcn_mfma_f32_16x16x32_bf16(b[0], a[0], c, 0, 0, 0); c = __builtin_amdgcn_mfma_f32_16x16x32_bf16(b[1], a[1], c, 0, 0, 0);
    }
}
template <bool F8, class Epi, class Sched>
__device__ __forceinline__ void gemm_phase(LAS unsigned char* lds, LAS unsigned char* xl, const Gemm g, const Sched& S, const Epi& E, const int tid) {
    const int wid = __builtin_amdgcn_readfirstlane(tid >> 6), lane = tid & 63, wr = wid >> 2, wc = wid & 3, fr = lane & 15, fq = lane >> 4;
    int sc1 = 0x7f7f7f7f; asm volatile("" : "+s"(sc1));
    int nt = g.K / BK; asm volatile("" : "+s"(nt));
    unsigned voffA[2], voffB[2]; int aoff, boff;
#define PG8_LANE_SETUP() do { const int t_ = tid_of(wid); const int fr_ = t_ & 15, fq_ = (t_ >> 4) & 3; \
        _Pragma("unroll") for (int i = 0; i < 2; ++i) { int R, C; stage_rc(t_ * 16 + i * 8192, R, C); const int Rb = (R & ~31) + perm32(R & 31); \
            voffA[i] = (unsigned)(R * g.lda + C) * 2u; voffB[i] = (unsigned)(Rb * g.ldb + C) * 2u; } \
        aoff = lds_byte(wr * 64 + fr_, fq_ * 8); boff = lds_byte(wc * 32 + fr_, fq_ * 8); } while (0)
    PG8_LANE_SETUP();
    const unsigned kstep = (unsigned)(BK * 2);
    const unsigned hstepA = (unsigned)HALF * g.lda * 2u, hstepB = (unsigned)HALF * g.ldb * 2u;
    const __amdgpu_buffer_rsrc_t srdA = __builtin_amdgcn_make_buffer_rsrc((void*)g.A, 0, 0x7fffffff, 0x00020000), srdB = __builtin_amdgcn_make_buffer_rsrc((void*)g.Bt, 0, 0x7fffffff, 0x00020000);
    const unsigned ldsw = (unsigned)wid * 1024u;
#define PG8_SA(b, h) (((b) * 2 + (h)) * HTB)
#define PG8_SB(b, h) ((4 + (b) * 2 + (h)) * HTB)
#define PG8_STAGE(bufoff, srd, goff, voff) do { _Pragma("unroll") for (int _i = 0; _i < 2; ++_i) \
        __builtin_amdgcn_raw_ptr_buffer_load_lds(srd, (LAS unsigned*)(lds + (bufoff) + ldsw + _i * 8192), 16, (voff)[_i], (goff), 0, 0); } while (0)
#define PG8_LDA(dst, b, h) do { _Pragma("unroll") for (int m = 0; m < 4; ++m) _Pragma("unroll") for (int k = 0; k < 2; ++k) dst[m][k] = *(const LAS bf16x8*)(lds + PG8_SA(b, h) + aoff + m * 2048 + k * 1024); } while (0)
#define PG8_LDB(dst, b, h) do { _Pragma("unroll") for (int n = 0; n < 2; ++n) _Pragma("unroll") for (int k = 0; k < 2; ++k) dst[n][k] = *(const LAS bf16x8*)(lds + PG8_SB(b, h) + boff + n * 2048 + k * 1024); } while (0)
#define PG8_MMA(ai, bj, At, Bt) do { __builtin_amdgcn_s_setprio(1); _Pragma("unroll") for (int m = 0; m < 4; ++m) _Pragma("unroll") for (int n = 0; n < 2; ++n) \
        mma_step<F8>(acc[ai][bj][m][n], Bt[n], At[m], sc1); __builtin_amdgcn_s_setprio(0); } while (0)
#define PG8_WAIT_V(n) asm volatile("s_waitcnt vmcnt(" #n ")" ::: "memory")
#define PG8_WAIT_L(n) asm volatile("s_waitcnt lgkmcnt(" #n ")" ::: "memory")
#define PG8_BAR __builtin_amdgcn_s_barrier()
#define PG8_SCHED __builtin_amdgcn_sched_barrier(0)
    Unit cur, nxt; int ui = 0;
    if (!S.next(0, cur)) return;
#define PG8_RSLOAD(u_, par_) do { if constexpr (Epi::RS_PREFETCH) { if (wid < 4) __builtin_amdgcn_raw_ptr_buffer_load_lds(srdR, (LAS unsigned*)(xl + (par_) * 4096 + wid * 1024), 16, \
        (unsigned)(tid_of(wid) & 63) * 16u, (unsigned)((u_).pm * BM + wid * 64) * 16u, 0, 0); } } while (0)
    __amdgpu_buffer_rsrc_t srdR; if constexpr (Epi::RS_PREFETCH) srdR = __builtin_amdgcn_make_buffer_rsrc((void*)E.rs, 0, 0x7fffffff, 0x00020000);
    PG8_RSLOAD(cur, 0);
    f32x4 acc[2][2][4][2];
#pragma unroll
    for (int a = 0; a < 2; ++a)
#pragma unroll
        for (int b = 0; b < 2; ++b)
#pragma unroll
            for (int m = 0; m < 4; ++m)
#pragma unroll
                for (int n = 0; n < 2; ++n) acc[a][b][m][n] = (f32x4){0.f, 0.f, 0.f, 0.f};
    bf16x8 At[4][2], B0[2][2], B1[2][2];
    unsigned cA = (unsigned)cur.aoff, cB = (unsigned)cur.boff;
    PG8_STAGE(PG8_SB(0, 0), srdB, cB, voffB); PG8_STAGE(PG8_SB(0, 1), srdB, cB + hstepB, voffB); PG8_STAGE(PG8_SA(0, 0), srdA, cA, voffA); PG8_STAGE(PG8_SA(0, 1), srdA, cA + hstepA, voffA);
    if (wr == 1) PG8_BAR;
    PG8_WAIT_V(2); PG8_BAR;
    PG8_STAGE(PG8_SB(1, 0), srdB, cB + kstep, voffB); PG8_STAGE(PG8_SA(1, 0), srdA, cA + kstep, voffA); PG8_STAGE(PG8_SB(1, 1), srdB, cB + hstepB + kstep, voffB);
    PG8_WAIT_V(6); PG8_BAR;
    for (;;) {
        const bool has_next = S.next(ui + 1, nxt);
        const unsigned nA = has_next ? (unsigned)nxt.aoff : cA, nB = has_next ? (unsigned)nxt.boff : cB;
        for (int t = 0; t < nt; t += 2) {
            const bool last = (t == nt - 2);
            const unsigned a1 = cA + (unsigned)(t + 1) * kstep;
            const unsigned a2 = last ? nA : cA + (unsigned)(t + 2) * kstep, b2 = last ? nB : cB + (unsigned)(t + 2) * kstep;
            const unsigned a3 = a2 + kstep, b3 = b2 + kstep;
            PG8_LDB(B0, 0, 0); PG8_LDB(B1, 0, 1); PG8_SCHED; PG8_LDA(At, 0, 0); PG8_STAGE(PG8_SA(1, 1), srdA, a1 + hstepA, voffA);
            PG8_WAIT_V(8); PG8_WAIT_L(0); PG8_BAR; PG8_MMA(0, 0, At, B0); PG8_MMA(0, 1, At, B1); PG8_BAR; PG8_SCHED;
            PG8_LDA(At, 0, 1); PG8_STAGE(PG8_SB(0, 0), srdB, b2, voffB); PG8_STAGE(PG8_SB(0, 1), srdB, b2 + hstepB, voffB); PG8_STAGE(PG8_SA(0, 0), srdA, a2, voffA);
            PG8_WAIT_V(8); PG8_WAIT_L(0); PG8_BAR; PG8_MMA(1, 0, At, B0); PG8_MMA(1, 1, At, B1); PG8_BAR; PG8_SCHED;
            PG8_LDB(B0, 1, 0); PG8_LDB(B1, 1, 1); PG8_SCHED; PG8_LDA(At, 1, 0); PG8_STAGE(PG8_SA(0, 1), srdA, a2 + hstepA, voffA);
            PG8_WAIT_V(8); PG8_WAIT_L(0); PG8_BAR; PG8_MMA(0, 0, At, B0); PG8_MMA(0, 1, At, B1); PG8_BAR; PG8_SCHED;
            PG8_LDA(At, 1, 1); PG8_STAGE(PG8_SB(1, 0), srdB, b3, voffB); PG8_STAGE(PG8_SB(1, 1), srdB, b3 + hstepB, voffB); PG8_STAGE(PG8_SA(1, 0), srdA, a3, voffA);
            PG8_WAIT_V(8); PG8_WAIT_L(0); PG8_BAR; PG8_MMA(1, 0, At, B0); PG8_MMA(1, 1, At, B1); PG8_BAR; PG8_SCHED;
        }
        if (wr == 0) PG8_BAR;
        E(acc, cur, wr, wc, fr, fq, Epi::RS_PREFETCH ? xl + (ui & 1) * 4096 : xl);
        if (!has_next) break;
#pragma unroll
        for (int a = 0; a < 2; ++a)
#pragma unroll
            for (int b = 0; b < 2; ++b)
#pragma unroll
                for (int m = 0; m < 4; ++m)
#pragma unroll
                    for (int n = 0; n < 2; ++n) acc[a][b][m][n] = (f32x4){0.f, 0.f, 0.f, 0.f};
        cur = nxt; cA = nA; cB = nB; ++ui;
        PG8_RSLOAD(cur, ui & 1);
        PG8_LANE_SETUP();
        if (wr == 1) PG8_BAR;
    }
    PG8_WAIT_V(0);
    PG8_BAR;
#undef PG8_LANE_SETUP
#undef PG8_RSLOAD
#undef PG8_SA
#undef PG8_SB
#undef PG8_STAGE
#undef PG8_LDA
#undef PG8_LDB
#undef PG8_MMA
#undef PG8_WAIT_V
#undef PG8_WAIT_L
#undef PG8_BAR
#undef PG8_SCHED
}
}

struct Args { const float* in[30]; float* out; unsigned char* ws; int ph_lo, ph_hi; };
enum { I_X = 0, I_MEM, I_RELB, I_LN_MIX_PRE, I_LN_MIX_POST, I_W_IN, I_PE_K, I_PE_V, I_CW_K, I_CW_V, I_CONV_W, I_CONV_B, I_LRU_WA, I_LRU_BA, I_LRU_WX, I_LRU_BX, I_LRU_LAM,
       I_GN_ATTN, I_GN_LRU, I_W_OUT, I_LN_X_PRE, I_LN_X_POST, I_LN_MEM, I_XQ, I_XKV, I_XO, I_LN_MLP_PRE, I_LN_MLP_POST, I_W1, I_W2 };

__device__ __forceinline__ void tr_item(const float* W, long ldw, bool kperm, bf16_t* WT, long ldt, int k0, int n0, int srccol, float nscale, const float* gain, LAS float* scr, int lane, bool f8 = false) {
    const int kr = lane >> 4, nq = lane & 15;
#pragma unroll 8
    for (int i = 0; i < 16; ++i) { const int kk = 4 * i + kr; const int k = k0 + kk; const long srow = kperm ? (long)((k & 63) * 64 + (k >> 6)) : (long)k;
        f32x4 v = {0.f, 0.f, 0.f, 0.f}; if (srccol >= 0) v = *(const f32x4*)(W + srow * ldw + srccol); float gs = nscale; if (gain) gs *= gain[k]; v *= gs;
        LAS float* d = scr + kk * 65 + 4 * nq; d[0] = v.x; d[1] = v.y; d[2] = v.z; d[3] = v.w; }
    LDS_WAIT(); asm volatile("" ::: "memory");
    const int c = lane & 7;
#pragma unroll
    for (int j = 0; j < 8; ++j) { const int n = (lane >> 3) + 8 * j; const LAS float* sp = scr + (8 * c) * 65 + n;
        if (f8) { int p0 = __builtin_amdgcn_cvt_pk_fp8_f32(sp[0 * 65], sp[1 * 65], 0, false); p0 = __builtin_amdgcn_cvt_pk_fp8_f32(sp[2 * 65], sp[3 * 65], p0, true);
            int p1 = __builtin_amdgcn_cvt_pk_fp8_f32(sp[4 * 65], sp[5 * 65], 0, false); p1 = __builtin_amdgcn_cvt_pk_fp8_f32(sp[6 * 65], sp[7 * 65], p1, true);
            *(u32x2*)((unsigned char*)WT + (size_t)(n0 + n) * ldt + k0 + 8 * c) = (u32x2){(unsigned)p0, (unsigned)p1}; continue; }
        u32x4 o; o.x = pk2(sp[0 * 65], sp[1 * 65]); o.y = pk2(sp[2 * 65], sp[3 * 65]); o.z = pk2(sp[4 * 65], sp[5 * 65]); o.w = pk2(sp[6 * 65], sp[7 * 65]);
        *(u32x4*)(WT + (size_t)(n0 + n) * ldt + k0 + 8 * c) = o; }
    LDS_WAIT(); asm volatile("" ::: "memory");
}
__device__ __forceinline__ int wina_srccol(int n) {
    if (n < 512) return n;
    if (n < 640) return n;
    if (n < 768) return 768 + (n - 640);
    if (n < 896) return 1024 + (n - 768);
    if (n < 920) return 1280 + (n - 896);
    if (n < 1024) return -1;
    if (n < 1536) return 1304 + (n - 1024);
    return 1816 + (n - 1536);
}
__device__ __forceinline__ int winv_srccol(int n) {
    if (n < 128) return 640 + n;
    if (n < 256) return 896 + (n - 128);
    if (n < 384) return 1152 + (n - 256);
    return -1;
}
__device__ __forceinline__ void norm_row_to_bf16(const float* xrow, bf16_t* orow, int lane) {
    const f32x4* xr = (const f32x4*)xrow + lane; f32x4 v[4]; float s = 0.f;
#pragma unroll
    for (int j = 0; j < 4; ++j) { v[j] = xr[64 * j]; s += (v[j].x * v[j].x + v[j].y * v[j].y) + (v[j].z * v[j].z + v[j].w * v[j].w); }
    const float r = 1.0f / sqrtf(wave_sum(s) * (1.f / D_) + EPS_);
    u32x2* o8 = (u32x2*)orow + lane;
#pragma unroll
    for (int j = 0; j < 4; ++j) { u32x2 w; w.x = pk2(v[j].x * r, v[j].y * r); w.y = pk2(v[j].z * r, v[j].w * r); o8[64 * j] = w; }
}
__device__ __forceinline__ void prologue_phase(const Args& A, LAS unsigned char* lds, int tid, int wave, int lane) {
    LAS float* scr = (LAS float*)(lds + wave * 17408);
    const int gw = blockIdx.x * 8 + wave, NGW = gridDim.x * 8;
    constexpr int C0 = 512, C1 = C0 + 128, C2 = C1 + 256, C3 = C2 + 256, C4 = C3 + 256, C5 = C4 + 256, C6 = C5 + 256, C7 = C6 + 1024, C8 = C7 + 1024, C9 = C8 + 64, C10 = C9 + 64, C11 = C10 + 8, C12 = C11 + 8;
    for (int it = gw; it < NL_ * C12; it += NGW) {
        const int l = it / C12; int r = it % C12;
        unsigned char* wl = A.ws + WS_W + (size_t)l * WL_STRIDE;
        const int nl = 4 * (lane & 15);
        if (r < C0) { const int kb = r / 32, nb = r % 32; const int n = nb * 64 + nl;
            tr_item(A.in[I_W_IN] + (size_t)l * D_ * INC_, INC_, false, (bf16_t*)(wl + W_INA), D_, kb * 64, nb * 64, wina_srccol(n), n < 512 ? C2_ : 1.0f, A.in[I_LN_MIX_PRE] + l * D_, scr, lane); continue; }
        if (r < C1) { r -= C0; const int kb = r / 8, nb = r % 8; const int n = nb * 64 + nl;
            tr_item(A.in[I_W_IN] + (size_t)l * D_ * INC_, INC_, false, (bf16_t*)(wl + W_INV), D_, kb * 64, nb * 64, winv_srccol(n), 1.0f, A.in[I_LN_MIX_PRE] + l * D_, scr, lane); continue; }
        if (r < C2) { r -= C1; const int kb = r / 16, nb = r % 16;
            const float* gain = (kb < 8) ? A.in[I_GN_ATTN] + l * 512 : A.in[I_GN_LRU] + l * 512 - 512;
            tr_item(A.in[I_W_OUT] + (size_t)l * D_ * D_, D_, false, (bf16_t*)(wl + W_OUT), D_, kb * 64, nb * 64, nb * 64 + nl, 1.0f, gain, scr, lane); continue; }
        if (r < C3) { r -= C2; const int kb = r / 16, nb = r % 16;
            tr_item(A.in[I_XQ] + (size_t)l * D_ * D_, D_, false, (bf16_t*)(wl + W_XQ), D_, kb * 64, nb * 64, nb * 64 + nl, XC2_, A.in[I_LN_X_PRE] + l * D_, scr, lane); continue; }
        if (r < C4) { r -= C3; const int kb = r / 16, nb = r % 16;
            tr_item(A.in[I_XKV] + (size_t)l * D_ * 2 * D_, 2 * D_, false, (bf16_t*)(wl + W_XK), D_, kb * 64, nb * 64, nb * 64 + nl, 1.0f, A.in[I_LN_MEM] + l * D_, scr, lane); continue; }
        if (r < C5) { r -= C4; const int kb = r / 16, nb = r % 16;
            tr_item(A.in[I_XKV] + (size_t)l * D_ * 2 * D_, 2 * D_, false, (bf16_t*)(wl + W_XV), D_, kb * 64, nb * 64, 1024 + nb * 64 + nl, 1.0f, A.in[I_LN_MEM] + l * D_, scr, lane); continue; }
        if (r < C6) { r -= C5; const int kb = r / 16, nb = r % 16;
            tr_item(A.in[I_XO] + (size_t)l * D_ * D_, D_, false, (bf16_t*)(wl + W_XO), D_, kb * 64, nb * 64, nb * 64 + nl, 1.0f, nullptr, scr, lane); continue; }
        if (r < C7) { r -= C6; const int kb = r / 64, nb = r % 64;
            tr_item(A.in[I_W1] + (size_t)l * D_ * FF_, FF_, false, (bf16_t*)(wl + W_1), D_, kb * 64, nb * 64, nb * 64 + nl, 1.0f, A.in[I_LN_MLP_PRE] + l * D_, scr, lane); continue; }
        if (r < C8) { r -= C7; const int kb = r / 16, nb = r % 16;
            tr_item(A.in[I_W2] + (size_t)l * FF_ * D_, D_, false, (bf16_t*)(wl + W_2), FF_, kb * 64, nb * 64, nb * 64 + nl, W8_SCALE, nullptr, scr, lane, true); continue; }
        if (r < C10) { r -= C8; const int isv = r >> 6; r &= 63;
            const float* W = A.in[isv ? I_CW_V : I_CW_K] + (size_t)l * 4096 * 64; bf16_t* WF = (bf16_t*)(wl + (isv ? W_CV : W_CK)); const float* pe = A.in[isv ? I_PE_V : I_PE_K] + l * 4096;
            const int kr = lane >> 4, nq = lane & 15; f32x4 pacc = {0.f, 0.f, 0.f, 0.f};
#pragma unroll 8
            for (int i = 0; i < 16; ++i) { const int kk = 4 * i + kr; const int srck = isv ? (kk * 64 + r) : (r * 64 + kk);
                const f32x4 v = *(const f32x4*)(W + (size_t)srck * 64 + 4 * nq); pacc += v * pe[srck];
                LAS float* d = scr + kk * 65 + 4 * nq; d[0] = v.x; d[1] = v.y; d[2] = v.z; d[3] = v.w; }
#pragma unroll
            for (int cc = 0; cc < 4; ++cc) { pacc[cc] += shx(pacc[cc], 16); pacc[cc] += shx(pacc[cc], 32); }
            if (lane < 16) *(f32x4*)((float*)(A.ws + WS_PEP) + (size_t)((l * 2 + isv) * 64 + r) * 64 + 4 * nq) = pacc;
            LDS_WAIT(); asm volatile("" ::: "memory");
            const int r32 = lane & 31, hi = lane >> 5;
#pragma unroll
            for (int c8 = 0; c8 < 8; ++c8) { const int ksl = c8 >> 1, half = c8 & 1; const LAS float* sp = scr + (ksl * 16 + 8 * hi) * 65 + half * 32 + r32;
                u32x4 w; w.x = pk2(sp[0 * 65], sp[1 * 65]); w.y = pk2(sp[2 * 65], sp[3 * 65]); w.z = pk2(sp[4 * 65], sp[5 * 65]); w.w = pk2(sp[6 * 65], sp[7 * 65]);
                *(u32x4*)(WF + ((size_t)((r * 4 + ksl) * 2 + half) * 64 + lane) * 8) = w; }
            LDS_WAIT(); asm volatile("" ::: "memory");
            continue; }
        if (r < C11) { r -= C10;
            tr_item(A.in[I_LRU_WA] + (size_t)(l * 8 + r) * 4096, 64, false, (bf16_t*)(wl + W_A) + r * 4096, 64, 0, 0, nl, 1.0f, nullptr, scr, lane); continue; }
        { r -= C11;
            tr_item(A.in[I_LRU_WX] + (size_t)(l * 8 + r) * 4096, 64, false, (bf16_t*)(wl + W_X) + r * 4096, 64, 0, 0, nl, 1.0f, nullptr, scr, lane); }
    }
    for (int m = gw; m < T_; m += NGW) {
        const f32x4* xr = (const f32x4*)(A.in[I_X] + (size_t)m * D_) + lane; f32x4 v[4]; float sq = 0.f;
#pragma unroll
        for (int j = 0; j < 4; ++j) { v[j] = xr[64 * j]; sq += (v[j].x * v[j].x + v[j].y * v[j].y) + (v[j].z * v[j].z + v[j].w * v[j].w); }
        sq = wave_sum(sq); if (lane == 0) ((f32x4*)(A.ws + WS_RS))[m] = (f32x4){sq, 0.f, 0.f, 0.f};
        u32x2* o8 = (u32x2*)((bf16_t*)(A.ws + WS_HB) + (size_t)m * D_) + lane;
#pragma unroll
        for (int j = 0; j < 4; ++j) { u32x2 w; w.x = pk2(v[j].x, v[j].y); w.y = pk2(v[j].z, v[j].w); o8[64 * j] = w; } }
    for (int m = gw; m < NB_ * MEM_; m += NGW) norm_row_to_bf16(A.in[I_MEM] + (size_t)m * D_, (bf16_t*)(A.ws + WS_MNB) + (size_t)m * D_, lane);
    { unsigned z = 0u; asm volatile("" : "+v"(z));
      for (int i = blockIdx.x * NTHREADS + tid; i < 128 * 4 * 256; i += gridDim.x * NTHREADS) ((u32x2*)(A.ws + WS_SLOT))[i] = (u32x2){z, z};
      for (int i = blockIdx.x * NTHREADS + tid; i < NL_ * 512 * 512; i += gridDim.x * NTHREADS) ((u32x2*)(A.ws + WS_AGG2))[i] = (u32x2){z, z}; }
}

__device__ __forceinline__ void compress_item(const Args& A, int l, int item, LAS unsigned char* lds, int wave) {
    const int tid = tid_of(wave); const int lane = tid & 63;
    const int which = item >> 6, rt = (item >> 1) & 31, half = item & 1;
    const int r32 = lane & 31, hi = lane >> 5;
    const int row = rt * 32 + r32;
    const int g = row >> 9, b = (row >> 7) & 3, n = row & 127;
    const bf16_t* Wf = (const bf16_t*)(A.ws + WS_W + (size_t)l * WL_STRIDE + (which ? W_CV : W_CK)) + ((size_t)((wave * 32) * 2 + half) * 64 + lane) * 8;
    const bf16_t* Ak = (const bf16_t*)(A.ws + WS_KP) + ((size_t)g * T_ + (size_t)b * S_ + n * 64) * 64 + wave * 512 + 8 * hi;
    const bf16_t* Av = (const bf16_t*)(A.ws + WS_VT) + (size_t)(g * 64 + wave * 8) * T_ + (size_t)b * S_ + n * 64 + 8 * hi;
    float bp = 0.f;
    { const float* pp = (const float*)(A.ws + WS_PEP) + (size_t)((l * 2 + which) * 64 + wave * 8) * 64 + lane;
#pragma unroll
      for (int i = 0; i < 8; ++i) bp += pp[i * 64]; }
    f32x16 c0 = {};
#pragma unroll 8
    for (int ks = 0; ks < 32; ++ks) {
        const bf16x8 af = which ? *(const bf16x8*)(Av + (size_t)(ks >> 2) * T_ + (ks & 3) * 16) : *(const bf16x8*)(Ak + ks * 16);
        const bf16x8 b0 = *(const bf16x8*)(Wf + ks * 1024);
        c0 = __builtin_amdgcn_mfma_f32_32x32x16_bf16(af, b0, c0, 0, 0, 0); }
    LAS float* red = (LAS float*)lds + wave * 1024;
#pragma unroll
    for (int r = 0; r < 16; ++r) red[crow(r, hi) * 32 + r32] = c0[r];
    ((LAS float*)lds)[8 * 1024 + tid] = bp;
    __syncthreads();
    { const int orow = rt * 32 + (tid >> 4), e0 = half * 32 + (tid & 15) * 2;
      float s0 = 0.f, s1 = 0.f;
#pragma unroll
      for (int w = 0; w < 8; ++w) { s0 += ((LAS float*)lds)[8 * 1024 + w * 64 + e0]; s1 += ((LAS float*)lds)[8 * 1024 + w * 64 + e0 + 1]; }
#pragma unroll
      for (int w = 0; w < 8; ++w) { const f32x2 v = *(const LAS f32x2*)((LAS float*)lds + w * 1024 + tid * 2); s0 += v.x; s1 += v.y; }
      if (which == 0) *(unsigned*)((bf16_t*)(A.ws + WS_KCB) + (size_t)orow * 64 + e0) = pk2(s0, s1);
      else { bf16_t* vct = (bf16_t*)(A.ws + WS_VCT) + (size_t)(orow >> 7) * 8192 + (orow & 127); vct[(e0 + 0) * 128] = (bf16_t)f2bf(s0); vct[(e0 + 1) * 128] = (bf16_t)f2bf(s1); } }
    __syncthreads();
}

constexpr int LRU_WREG = 17408;
constexpr int LRU_XSS = 8 * LRU_WREG, LRU_CARRY = LRU_XSS + 2048;
__device__ __forceinline__ float one_minus_exp(float x) {
    float p = 1.0f + x * (1.0f / 6.0f); p = 1.0f + x * 0.2f * p; p = 1.0f + x * 0.25f * p; p = 1.0f + x * (1.0f / 3.0f) * p; p = 1.0f + x * 0.5f * p; return -x * p;
}
template <int PASS>
__device__ __forceinline__ void lru_item(const Args& A, int l, int b, int chunk, LAS unsigned char* lds, int wave) {
    const int tid = tid_of(wave); const int lane = tid & 63;
    const int n = wave, r32 = lane & 31, hi = lane >> 5;
    const size_t R0 = (size_t)b * S_ + (size_t)chunk * 64; const int t0 = chunk * 64;
    const bf16_t* XR = (const bf16_t*)(A.ws + WS_XR);
    float* AGG = (float*)(A.ws + WS_AGG);
    LAS unsigned char* wreg = lds + wave * LRU_WREG;
    u32x4 tv[9]; float wv[5];
    { const int c8 = lane & 7;
#pragma unroll
      for (int i = 0; i < 9; ++i) { const int rr = (lane >> 3) + 8 * i; const int tt = t0 + rr - 3; const bool ok = (rr < 67) && (tt >= 0);
          const long dr = ok ? (long)(rr - 3) : 0; const u32x4 v = *(const u32x4*)(XR + (R0 + dr) * 512 + n * 64 + c8 * 8); tv[i] = ok ? v : (u32x4){0u, 0u, 0u, 0u}; }
#pragma unroll
      for (int j = 0; j < 4; ++j) wv[j] = A.in[I_CONV_W][l * 2048 + j * 512 + n * 64 + lane];
      wv[4] = A.in[I_CONV_B][l * 512 + n * 64 + lane]; }
    if (PASS == 2) {
        const float* ag = AGG + (size_t)(b * 128) * 1024 + tid; float H = 0.f; int c = 0;
        for (; c + 16 <= chunk; c += 16) { float a_[16], b_[16];
#pragma unroll
            for (int q = 0; q < 16; ++q) { a_[q] = ag[(size_t)(c + q) * 1024]; b_[q] = ag[(size_t)(c + q) * 1024 + 512]; }
#pragma unroll
            for (int q = 0; q < 16; ++q) H = a_[q] * H + b_[q]; }
        for (; c < chunk; ++c) H = ag[(size_t)c * 1024] * H + ag[(size_t)c * 1024 + 512];
        ((LAS float*)(lds + LRU_CARRY))[tid] = H;
    }
    { const int c8 = lane & 7;
#pragma unroll
      for (int i = 0; i < 9; ++i) { const int rr = (lane >> 3) + 8 * i; if (rr < 67) *(LAS u32x4*)(wreg + rr * 144 + c8 * 16) = tv[i]; }
      LAS float* wl_ = (LAS float*)(wreg + 9728);
#pragma unroll
      for (int j = 0; j < 5; ++j) wl_[j * 64 + lane] = wv[j]; }
    LDS_WAIT(); asm volatile("" ::: "memory");
    bf16x8 xa[2][4];
    { const LAS float* wl_ = (const LAS float*)(wreg + 9728);
#pragma unroll
      for (int ks = 0; ks < 4; ++ks) { const int cl0 = 16 * ks + 8 * hi;
          f32x4 w0[4], w1[4];
#pragma unroll
          for (int j = 0; j < 4; ++j) { w0[j] = *(const LAS f32x4*)(wl_ + j * 64 + cl0); w1[j] = *(const LAS f32x4*)(wl_ + j * 64 + cl0 + 4); }
          const f32x4 b0 = *(const LAS f32x4*)(wl_ + 256 + cl0), b1 = *(const LAS f32x4*)(wl_ + 256 + cl0 + 4);
#pragma unroll
          for (int mt = 0; mt < 2; ++mt) { f32x4 a0 = b0, a1 = b1;
#pragma unroll
              for (int j = 0; j < 4; ++j) { const u32x4 v = *(const LAS u32x4*)(wreg + (32 * mt + r32 + j) * 144 + cl0 * 2);
                  a0 += w0[j] * (f32x4){bflo(v.x), bfhi(v.x), bflo(v.y), bfhi(v.y)}; a1 += w1[j] * (f32x4){bflo(v.z), bfhi(v.z), bflo(v.w), bfhi(v.w)}; }
              u32x4 pw; pw.x = pk2(a0.x, a0.y); pw.y = pk2(a0.z, a0.w); pw.z = pk2(a1.x, a1.y); pw.w = pk2(a1.z, a1.w);
              xa[mt][ks] = __builtin_bit_cast(bf16x8, pw); } } }
    if (PASS == 2) __syncthreads();
    else { LDS_WAIT(); asm volatile("" ::: "memory"); }
    const bf16_t* Wa = (const bf16_t*)(A.ws + WS_W + (size_t)l * WL_STRIDE + W_A) + n * 4096;
    const bf16_t* Wx = (const bf16_t*)(A.ws + WS_W + (size_t)l * WL_STRIDE + W_X) + n * 4096;
    LAS float* stage = (LAS float*)wreg;
#pragma unroll 1
    for (int nt = 0; nt < 2; ++nt) {
        const int e = 32 * nt + r32, ch = n * 64 + e;
        f32x16 Rr[2] = {}, Ii[2] = {}, Xc[2] = {};
#pragma unroll
        for (int ks = 0; ks < 4; ++ks) {
            const bf16x8 wa = *(const bf16x8*)(Wa + e * 64 + 16 * ks + 8 * hi), wx = *(const bf16x8*)(Wx + e * 64 + 16 * ks + 8 * hi);
            bf16x8 idf;
#pragma unroll
            for (int j = 0; j < 8; ++j) idf[j] = (16 * ks + 8 * hi + j == e) ? (short)0x3F80 : (short)0;
#pragma unroll
            for (int mt = 0; mt < 2; ++mt) {
                Rr[mt] = __builtin_amdgcn_mfma_f32_32x32x16_bf16(xa[mt][ks], wa, Rr[mt], 0, 0, 0);
                Ii[mt] = __builtin_amdgcn_mfma_f32_32x32x16_bf16(xa[mt][ks], wx, Ii[mt], 0, 0, 0);
                Xc[mt] = __builtin_amdgcn_mfma_f32_32x32x16_bf16(xa[mt][ks], idf, Xc[mt], 0, 0, 0); } }
        const float nba = -LOG2E_ * A.in[I_LRU_BA][l * 512 + ch], nbx = -LOG2E_ * A.in[I_LRU_BX][l * 512 + ch], lam = A.in[I_LRU_LAM][l * 512 + ch];
        const float cl2 = -8.0f * log1pf(expf(-lam)) * LOG2E_;
#pragma unroll
        for (int mt = 0; mt < 2; ++mt)
#pragma unroll
            for (int r = 0; r < 16; ++r) { const float rg = rcp(1.0f + ex2(__builtin_fmaf(Rr[mt][r], -LOG2E_, nba))), ig = rcp(1.0f + ex2(__builtin_fmaf(Ii[mt][r], -LOG2E_, nbx))); const float av = ex2(cl2 * rg);
                Rr[mt][r] = av; Ii[mt][r] = __builtin_amdgcn_sqrtf(__builtin_fmaf(-av, av, 1.0f)) * (ig * Xc[mt][r]); }
        float GA[8], GB[8];
#pragma unroll
        for (int gi = 0; gi < 8; ++gi) { const int mt = gi >> 2, i = gi & 3; float a = 1.f, bq = 0.f;
#pragma unroll
            for (int j = 0; j < 4; ++j) { const float aa = Rr[mt][4 * i + j]; bq = aa * bq + Ii[mt][4 * i + j]; a *= aa; }
            GA[gi] = a; GB[gi] = bq; }
        float H = 0.f;
        if (PASS == 2) H = ((const LAS float*)(lds + LRU_CARRY))[ch];
        float Hin[8]; float Atot = 1.f;
#pragma unroll
        for (int gi = 0; gi < 8; ++gi) {
            const auto ra = __builtin_amdgcn_permlane32_swap(__float_as_uint(GA[gi]), __float_as_uint(GA[gi]), false, false); const auto rb = __builtin_amdgcn_permlane32_swap(__float_as_uint(GB[gi]), __float_as_uint(GB[gi]), false, false);
            const float A0 = __uint_as_float(ra[0]), A1 = __uint_as_float(ra[1]), B0 = __uint_as_float(rb[0]), B1 = __uint_as_float(rb[1]);
            const float h0 = H; H = A0 * H + B0; const float h1 = H; H = A1 * H + B1; Hin[gi] = hi ? h1 : h0; Atot *= A0 * A1; }
        if (PASS == 1) { if (hi == 0) { float* ag = AGG + (size_t)(b * 128 + chunk) * 1024 + ch; ag[0] = Atot; ag[512] = H; } }
        else {
#pragma unroll
            for (int gi = 0; gi < 8; ++gi) { const int mt = gi >> 2, i = gi & 3; float h = Hin[gi];
#pragma unroll
                for (int j = 0; j < 4; ++j) { h = Rr[mt][4 * i + j] * h + Ii[mt][4 * i + j]; stage[(32 * mt + 8 * i + 4 * hi + j) * 68 + e] = h; } }
        }
    }
    if (PASS == 2) {
        LDS_WAIT(); asm volatile("" ::: "memory");
        const bf16_t* YG = (const bf16_t*)(A.ws + WS_YG); bf16_t* AB = (bf16_t*)(A.ws + WS_AB);
        LAS float* xss = (LAS float*)(lds + LRU_XSS);
        f32x4 v[8][2];
#pragma unroll
        for (int it = 0; it < 8; ++it) { const int row = it * 8 + (lane >> 3), c8 = lane & 7;
            if ((it & 1) == 0) asm volatile("" ::: "memory");
            const f32x4 h0 = *(const LAS f32x4*)(stage + row * 68 + c8 * 8), h1 = *(const LAS f32x4*)(stage + row * 68 + c8 * 8 + 4);
            const u32x4 y = *(const u32x4*)(YG + (R0 + row) * 512 + n * 64 + c8 * 8);
            v[it][0] = h0 * (f32x4){bflo(y.x), bfhi(y.x), bflo(y.y), bfhi(y.y)}; v[it][1] = h1 * (f32x4){bflo(y.z), bfhi(y.z), bflo(y.w), bfhi(y.w)};
            float ss = (v[it][0].x * v[it][0].x + v[it][0].y * v[it][0].y) + (v[it][0].z * v[it][0].z + v[it][0].w * v[it][0].w)
                     + (v[it][1].x * v[it][1].x + v[it][1].y * v[it][1].y) + (v[it][1].z * v[it][1].z + v[it][1].w * v[it][1].w);
            ss += __uint_as_float(__builtin_amdgcn_update_dpp(0u, __float_as_uint(ss), 0xB1, 0xF, 0xF, false)); ss += __uint_as_float(__builtin_amdgcn_update_dpp(0u, __float_as_uint(ss), 0x4E, 0xF, 0xF, false)); ss += __uint_as_float(__builtin_amdgcn_update_dpp(0u, __float_as_uint(ss), 0x141, 0xF, 0xF, false));
            if (c8 == 0) xss[wave * 64 + row] = ss; }
        __syncthreads();
#pragma unroll
        for (int it = 0; it < 8; ++it) { const int row = it * 8 + (lane >> 3), c8 = lane & 7; float tot = 0.f;
#pragma unroll
            for (int w = 0; w < 8; ++w) tot += xss[w * 64 + row];
            const float ri = 1.0f / sqrtf(tot * (1.f / 512.f) + EPS_);
            const f32x4 a = v[it][0] * ri, c = v[it][1] * ri;
            u32x4 o; o.x = pk2(a.x, a.y); o.y = pk2(a.z, a.w); o.z = pk2(c.x, c.y); o.w = pk2(c.z, c.w);
            *(u32x4*)(AB + (R0 + row) * 1024 + 512 + n * 64 + c8 * 8) = o; }
        __syncthreads();
    }
}


constexpr size_t WS_FLG = 32768;
__device__ __forceinline__ void lru_item_1p(const Args& A, int l, int b, int chunk, LAS unsigned char* lds, int wave) {
    const int tid = tid_of(wave); const int lane = tid & 63;
    const int n = wave, r32 = lane & 31, hi = lane >> 5;
    const size_t R0 = (size_t)b * S_ + (size_t)chunk * 64; const int t0 = chunk * 64;
    const bf16_t* XR = (const bf16_t*)(A.ws + WS_XR);
    unsigned long long* AGG2 = (unsigned long long*)(A.ws + WS_AGG2) + (size_t)(l * 512 + b * 128) * 512;
    LAS unsigned char* wreg = lds + wave * LRU_WREG;
    u32x4 tv[9]; float wv[5];
    const bf16_t* Wa = (const bf16_t*)(A.ws + WS_W + (size_t)l * WL_STRIDE + W_A) + n * 4096;
    const bf16_t* Wx = (const bf16_t*)(A.ws + WS_W + (size_t)l * WL_STRIDE + W_X) + n * 4096;
    float nbav[2], nbxv[2], lamv[2];
    { const int c8 = lane & 7;
#pragma unroll
      for (int i = 0; i < 9; ++i) { const int rr = (lane >> 3) + 8 * i; const int tt = t0 + rr - 3; const bool ok = (rr < 67) && (tt >= 0);
          const long dr = ok ? (long)(rr - 3) : 0; const u32x4 v = *(const u32x4*)(XR + (R0 + dr) * 512 + n * 64 + c8 * 8); tv[i] = ok ? v : (u32x4){0u, 0u, 0u, 0u}; }
#pragma unroll
      for (int j = 0; j < 4; ++j) wv[j] = A.in[I_CONV_W][l * 2048 + j * 512 + n * 64 + lane];
      wv[4] = A.in[I_CONV_B][l * 512 + n * 64 + lane];
#pragma unroll
      for (int nt = 0; nt < 2; ++nt) { const int e = 32 * nt + r32, ch = n * 64 + e;
          nbav[nt] = A.in[I_LRU_BA][l * 512 + ch]; nbxv[nt] = A.in[I_LRU_BX][l * 512 + ch]; lamv[nt] = A.in[I_LRU_LAM][l * 512 + ch]; } }
    { const int c8 = lane & 7;
#pragma unroll
      for (int i = 0; i < 9; ++i) { const int rr = (lane >> 3) + 8 * i; if (rr < 67) *(LAS u32x4*)(wreg + rr * 144 + c8 * 16) = tv[i]; }
      LAS float* wl_ = (LAS float*)(wreg + 9728);
#pragma unroll
      for (int j = 0; j < 5; ++j) wl_[j * 64 + lane] = wv[j]; }
    LDS_WAIT(); asm volatile("" ::: "memory");
    bf16x8 xa[2][4];
    { const LAS float* wl_ = (const LAS float*)(wreg + 9728);
#pragma unroll
      for (int ks = 0; ks < 4; ++ks) { const int cl0 = 16 * ks + 8 * hi;
          f32x4 w0[4], w1[4];
#pragma unroll
          for (int j = 0; j < 4; ++j) { w0[j] = *(const LAS f32x4*)(wl_ + j * 64 + cl0); w1[j] = *(const LAS f32x4*)(wl_ + j * 64 + cl0 + 4); }
          const f32x4 b0 = *(const LAS f32x4*)(wl_ + 256 + cl0), b1 = *(const LAS f32x4*)(wl_ + 256 + cl0 + 4);
#pragma unroll
          for (int mt = 0; mt < 2; ++mt) { f32x4 a0 = b0, a1 = b1;
#pragma unroll
              for (int j = 0; j < 4; ++j) { const u32x4 v = *(const LAS u32x4*)(wreg + (32 * mt + r32 + j) * 144 + cl0 * 2);
                  a0 += w0[j] * (f32x4){bflo(v.x), bfhi(v.x), bflo(v.y), bfhi(v.y)}; a1 += w1[j] * (f32x4){bflo(v.z), bfhi(v.z), bflo(v.w), bfhi(v.w)}; }
              u32x4 pw; pw.x = pk2(a0.x, a0.y); pw.y = pk2(a0.z, a0.w); pw.z = pk2(a1.x, a1.y); pw.w = pk2(a1.z, a1.w);
              xa[mt][ks] = __builtin_bit_cast(bf16x8, pw); } } }
    f32x16 Av[2][2], Bv[2][2];
#pragma unroll
    for (int nt = 0; nt < 2; ++nt) {
        const int e = 32 * nt + r32, ch = n * 64 + e;
        f32x16 Rr[2] = {}, Ii[2] = {}, Xc[2] = {};
#pragma unroll
        for (int ks = 0; ks < 4; ++ks) {
            const bf16x8 wa = *(const bf16x8*)(Wa + e * 64 + 16 * ks + 8 * hi), wx = *(const bf16x8*)(Wx + e * 64 + 16 * ks + 8 * hi);
            bf16x8 idf;
#pragma unroll
            for (int j = 0; j < 8; ++j) idf[j] = (16 * ks + 8 * hi + j == e) ? (short)0x3F80 : (short)0;
#pragma unroll
            for (int mt = 0; mt < 2; ++mt) {
                Rr[mt] = __builtin_amdgcn_mfma_f32_32x32x16_bf16(xa[mt][ks], wa, Rr[mt], 0, 0, 0);
                Ii[mt] = __builtin_amdgcn_mfma_f32_32x32x16_bf16(xa[mt][ks], wx, Ii[mt], 0, 0, 0);
                Xc[mt] = __builtin_amdgcn_mfma_f32_32x32x16_bf16(xa[mt][ks], idf, Xc[mt], 0, 0, 0); } }
        const float nba = -LOG2E_ * nbav[nt], nbx = -LOG2E_ * nbxv[nt], lam = lamv[nt];
        const float xl_ = ex2(-LOG2E_ * lam);
        const float cl2 = -8.0f * LOG2E_ * (xl_ < 0.03f ? xl_ * (1.0f - xl_ * (0.5f - xl_ * (0.33333334f - xl_ * 0.25f))) : __builtin_amdgcn_logf(1.0f + xl_) * 0.69314718f);
#pragma unroll
        for (int mt = 0; mt < 2; ++mt)
#pragma unroll
            for (int r = 0; r < 16; ++r) { const float rg = rcp(1.0f + ex2(__builtin_fmaf(Rr[mt][r], -LOG2E_, nba))), ig = rcp(1.0f + ex2(__builtin_fmaf(Ii[mt][r], -LOG2E_, nbx))); const float av = ex2(cl2 * rg);
                Av[nt][mt][r] = av; Bv[nt][mt][r] = __builtin_amdgcn_sqrtf(__builtin_fmaf(-av, av, 1.0f)) * (ig * Xc[mt][r]); }
        float H = 0.f, Atot = 1.f;
#pragma unroll
        for (int gi = 0; gi < 8; ++gi) { const int mt = gi >> 2, i = gi & 3; float a = 1.f, bq = 0.f;
#pragma unroll
            for (int j = 0; j < 4; ++j) { const float aa = Av[nt][mt][4 * i + j]; bq = aa * bq + Bv[nt][mt][4 * i + j]; a *= aa; }
            const auto ra = __builtin_amdgcn_permlane32_swap(__float_as_uint(a), __float_as_uint(a), false, false); const auto rb = __builtin_amdgcn_permlane32_swap(__float_as_uint(bq), __float_as_uint(bq), false, false);
            const float A0 = __uint_as_float(ra[0]), A1 = __uint_as_float(ra[1]), B0 = __uint_as_float(rb[0]), B1 = __uint_as_float(rb[1]);
            H = A0 * H + B0; H = A1 * H + B1; Atot *= A0 * A1; }
        if (hi == 0) __hip_atomic_store(AGG2 + (size_t)chunk * 512 + ch, ((unsigned long long)__float_as_uint(H) << 32) | (unsigned long long)__float_as_uint(fmaxf(Atot, 1e-37f)),
                                        __ATOMIC_RELAXED, __HIP_MEMORY_SCOPE_AGENT);
    }
    { const int tidF = tid_of(wave); const unsigned long long* ag = AGG2 + tidF; float H = 0.f;
      for (int c = 0; c < chunk; c += 16) { unsigned long long v[16]; unsigned sp = 0;
          for (;;) { bool ok = true;
#pragma unroll
              for (int q = 0; q < 16; ++q) { const int cc = (c + q < chunk) ? c + q : chunk - 1; v[q] = __hip_atomic_load(ag + (size_t)cc * 512, __ATOMIC_RELAXED, __HIP_MEMORY_SCOPE_AGENT); ok = ok && ((unsigned)v[q] != 0u); }
              if (ok) break;
              __builtin_amdgcn_s_sleep(2); if (++sp > (1u << 22)) break; }
#pragma unroll
          for (int q = 0; q < 16; ++q) H = (c + q < chunk) ? __uint_as_float((unsigned)v[q]) * H + __uint_as_float((unsigned)(v[q] >> 32)) : H; }
      ((LAS float*)(lds + LRU_CARRY))[tidF] = H; }
    const bf16_t* YG = (const bf16_t*)(A.ws + WS_YG);
    u32x4 yv[8];
#pragma unroll
    for (int it = 0; it < 8; ++it) { const int laneY = tid_of(wave) & 63; yv[it] = *(const u32x4*)(YG + (R0 + it * 8 + (laneY >> 3)) * 512 + n * 64 + (laneY & 7) * 8); }
    __syncthreads();
    LAS float* stage = (LAS float*)wreg;
    const int tid3 = tid_of(wave); const int hi3 = (tid3 >> 5) & 1;
#pragma unroll
    for (int nt = 0; nt < 2; ++nt) {
        const int e = 32 * nt + r32, ch = n * 64 + e;
        float H = ((const LAS float*)(lds + LRU_CARRY))[ch];
#pragma unroll
        for (int gi = 0; gi < 8; ++gi) { const int mt = gi >> 2, i = gi & 3; float a = 1.f, bq = 0.f;
#pragma unroll
            for (int j = 0; j < 4; ++j) { const float aa = Av[nt][mt][4 * i + j]; bq = aa * bq + Bv[nt][mt][4 * i + j]; a *= aa; }
            const auto ra = __builtin_amdgcn_permlane32_swap(__float_as_uint(a), __float_as_uint(a), false, false); const auto rb = __builtin_amdgcn_permlane32_swap(__float_as_uint(bq), __float_as_uint(bq), false, false);
            const float A0 = __uint_as_float(ra[0]), A1 = __uint_as_float(ra[1]), B0 = __uint_as_float(rb[0]), B1 = __uint_as_float(rb[1]);
            const float h0 = H; H = A0 * H + B0; const float h1 = H; H = A1 * H + B1;
            float h = hi3 ? h1 : h0;
#pragma unroll
            for (int j = 0; j < 4; ++j) { h = Av[nt][mt][4 * i + j] * h + Bv[nt][mt][4 * i + j]; stage[(32 * mt + 8 * i + 4 * hi3 + j) * 68 + e] = h; } }
    }
    LDS_WAIT(); asm volatile("" ::: "memory");
    { bf16_t* AB = (bf16_t*)(A.ws + WS_AB); const int laneO = tid_of(wave) & 63;
      LAS float* xss = (LAS float*)(lds + LRU_XSS);
      f32x4 v[8][2];
#pragma unroll
      for (int it = 0; it < 8; ++it) { const int row = it * 8 + (laneO >> 3), c8 = laneO & 7;
          const f32x4 h0 = *(const LAS f32x4*)(stage + row * 68 + c8 * 8), h1 = *(const LAS f32x4*)(stage + row * 68 + c8 * 8 + 4);
          const u32x4 y = yv[it];
          v[it][0] = h0 * (f32x4){bflo(y.x), bfhi(y.x), bflo(y.y), bfhi(y.y)}; v[it][1] = h1 * (f32x4){bflo(y.z), bfhi(y.z), bflo(y.w), bfhi(y.w)};
          float ss = (v[it][0].x * v[it][0].x + v[it][0].y * v[it][0].y) + (v[it][0].z * v[it][0].z + v[it][0].w * v[it][0].w)
                   + (v[it][1].x * v[it][1].x + v[it][1].y * v[it][1].y) + (v[it][1].z * v[it][1].z + v[it][1].w * v[it][1].w);
          ss += __uint_as_float(__builtin_amdgcn_update_dpp(0u, __float_as_uint(ss), 0xB1, 0xF, 0xF, false)); ss += __uint_as_float(__builtin_amdgcn_update_dpp(0u, __float_as_uint(ss), 0x4E, 0xF, 0xF, false)); ss += __uint_as_float(__builtin_amdgcn_update_dpp(0u, __float_as_uint(ss), 0x141, 0xF, 0xF, false));
          if (c8 == 0) xss[row * 8 + wave] = ss; }
      __syncthreads();
#pragma unroll
      for (int it = 0; it < 8; ++it) { const int row = it * 8 + (laneO >> 3), c8 = laneO & 7;
          const f32x4 p0 = *(const LAS f32x4*)(xss + row * 8), p1 = *(const LAS f32x4*)(xss + row * 8 + 4);
          const float tot = ((((((p0.x + p0.y) + p0.z) + p0.w) + p1.x) + p1.y) + p1.z) + p1.w;
          const float ri = __builtin_amdgcn_rsqf(tot * (1.f / 512.f) + EPS_);
          const f32x4 a = v[it][0] * ri, c = v[it][1] * ri;
          u32x4 o; o.x = pk2(a.x, a.y); o.y = pk2(a.z, a.w); o.z = pk2(c.x, c.y); o.w = pk2(c.z, c.w);
          *(u32x4*)(AB + (R0 + row) * 1024 + 512 + n * 64 + c8 * 8) = o; }
      __syncthreads(); }
}

constexpr int NS_KV = 0, NS_KC = 0, NS_VC = 18432, NS_IMP = 35840;
constexpr int NS_OSP = 0, NS_LSP = 66560, NS_MREF = 67584, NS_QT = 69632, NS_SLOT = 102400;
constexpr int NS_SEL = 103936, NS_LUT = 104960, NS_SS = 111104, NS_ATT = 111616, NS_QCTR = 145408;
constexpr int LUTN = 192;
constexpr int NS_BKT = NS_LUT + 1024, NS_ELUT = NS_LUT + 1152;
constexpr int OSPP = 65;
constexpr int KPITCH = 144;
constexpr int VCPITCH = 272;
constexpr int IMPP = 132;
constexpr int ATTP = 264;


struct SoftSt { float m, l; f32x16 o[2]; };
#define MX3(a, b, c) __builtin_fmaxf(__builtin_fmaxf((a), (b)), (c))
__device__ __forceinline__ void attn_step(const LAS unsigned char* Kt, const LAS unsigned char* Vt, const bf16x8 (&qr)[4], float cinit, bool masked, bool first,
                                          const LAS float* bp, SoftSt& st, int r32, int hi) {
    bf16x8 kf[2][4];
#pragma unroll
    for (int kt = 0; kt < 2; ++kt)
#pragma unroll
        for (int ds = 0; ds < 4; ++ds) kf[kt][ds] = *(const LAS bf16x8*)(Kt + (32 * kt + r32) * KPITCH + (16 * ds + 8 * hi) * 2);
    __builtin_amdgcn_sched_barrier(0);
    f32x16 sc[2], cvec;
    const float c0 = cinit - st.m;
#pragma unroll
    for (int r = 0; r < 16; ++r) cvec[r] = c0;
#pragma unroll
    for (int ds = 0; ds < 4; ++ds)
#pragma unroll
        for (int kt = 0; kt < 2; ++kt) sc[kt] = __builtin_amdgcn_mfma_f32_32x32x16_bf16(kf[kt][ds], qr[ds], ds == 0 ? cvec : sc[kt], 0, 0, 0);
    bf16x8 vf[2][2][2];
#pragma unroll
    for (int kt = 0; kt < 2; ++kt)
#pragma unroll
        for (int s = 0; s < 2; ++s)
#pragma unroll
            for (int dt = 0; dt < 2; ++dt) vf[kt][s][dt] = *(const LAS bf16x8*)(Vt + (32 * dt + r32) * KPITCH + (32 * kt + 16 * s + 8 * hi) * 2);
    __builtin_amdgcn_sched_barrier(0);
    if (masked) {
#pragma unroll
        for (int kt = 0; kt < 2; ++kt)
#pragma unroll
            for (int r = 0; r < 16; ++r) sc[kt][r] += bp[59 - 32 * kt - (r & 3) - 8 * (r >> 2)];
    }
    float mx = MX3(sc[0][0], sc[1][0], sc[0][1]);
#pragma unroll
    for (int r = 2; r < 16; r += 2) mx = MX3(mx, sc[0][r], sc[1][r - 1]), mx = MX3(mx, sc[0][r + 1], sc[1][r]);
    mx = fmaxf(mx, sc[1][15]);
    mx = max32(mx);
    if (first || __any(mx > 8.0f)) { const float dl = first ? mx : fmaxf(mx, 0.f); const float corr = ex2(-dl); st.m += dl; st.l *= corr;
#pragma unroll
        for (int kt = 0; kt < 2; ++kt)
#pragma unroll
            for (int r = 0; r < 16; ++r) { sc[kt][r] -= dl; st.o[kt][r] *= corr; } }
    f32x2 ls2 = {0.f, 0.f};
#pragma unroll
    for (int kt = 0; kt < 2; ++kt)
#pragma unroll
        for (int s = 0; s < 2; ++s) {
#pragma unroll
            for (int j = 0; j < 8; j += 2) { const float e0 = ex2(sc[kt][8 * s + j]), e1 = ex2(sc[kt][8 * s + j + 1]); sc[kt][8 * s + j] = e0; sc[kt][8 * s + j + 1] = e1; ls2 += (f32x2){e0, e1}; }
            u32x4 pw; pw.x = cvt_pk_bf16(sc[kt][8 * s + 0], sc[kt][8 * s + 1]); pw.y = cvt_pk_bf16(sc[kt][8 * s + 2], sc[kt][8 * s + 3]);
            pw.z = cvt_pk_bf16(sc[kt][8 * s + 4], sc[kt][8 * s + 5]); pw.w = cvt_pk_bf16(sc[kt][8 * s + 6], sc[kt][8 * s + 7]);
            const bf16x8 pf = __builtin_bit_cast(bf16x8, pw);
#pragma unroll
            for (int dt = 0; dt < 2; ++dt) st.o[dt] = __builtin_amdgcn_mfma_f32_32x32x16_bf16(vf[kt][s][dt], pf, st.o[dt], 0, 0, 0); }
    st.l += ls2.x + ls2.y;
}

#define NSA_IDS() const int tid = tid_of(wave); const int lane = tid & 63, r32 = lane & 31, hi = lane >> 5; const int tl = 8 * wave + (r32 >> 2), hh = r32 & 3; \
    const int tq = 64 * tile + tl; const size_t R = rowbase + tq; const int hg = g * 4 + hh; const LAS float* lut_h = (const LAS float*)(lds + NS_LUT) + hg; (void)lane; (void)R; (void)lut_h; (void)tq; (void)hi
#define NSA_LOADQ() bf16x8 qr[4]; _Pragma("unroll") for (int ds = 0; ds < 4; ++ds) qr[ds] = *(const LAS bf16x8*)(lds + NS_QT + (32 * wave + r32) * 128 + (((2 * ds + hi) ^ (r32 & 7)) << 4))

template <int variant>
__device__ __forceinline__ void nsa_item(const Args& A, int l, int b, int tile, LAS unsigned char* lds, int wave) {
    const int cur = tile; const size_t rowbase = (size_t)b * S_;
    const int nkb = cur >= 64 ? 2 : 1;
#pragma unroll 1
    for (int g = 0; g < 2; ++g) {
        float gate3[3];
        { NSA_IDS(); const float* gp = (const float*)(A.ws + WS_GATES) + R * 24 + hg * 3; gate3[0] = gp[0]; gate3[1] = gp[1]; gate3[2] = gp[2]; }
        {
            NSA_IDS();
            LAS float* imp = (LAS float*)(lds + NS_IMP);
            { const bf16_t* kcb = (const bf16_t*)(A.ws + WS_KCB) + (size_t)(g * 4 + b) * 128 * 64; const bf16_t* vct = (const bf16_t*)(A.ws + WS_VCT) + (size_t)(g * 4 + b) * 8192;
              u32x4 kv[2], vv[2], qv[4];
#pragma unroll
              for (int i = 0; i < 2; ++i) { const int idx = tid + NTHREADS * i; kv[i] = *(const u32x4*)(kcb + idx * 8); vv[i] = *(const u32x4*)(vct + idx * 8); }
#pragma unroll
              for (int i = 0; i < 4; ++i) { const int idx = tid + NTHREADS * i; const int row = idx >> 3, c = idx & 7;
                  qv[i] = *(const u32x4*)((const bf16_t*)(A.ws + WS_QB) + (rowbase + 64 * tile + (row >> 2)) * 512 + (g * 4 + (row & 3)) * 64 + c * 8); }
#pragma unroll
              for (int i = 0; i < 4; ++i) { const int idx = tid + NTHREADS * i; const int row = idx >> 3, c = idx & 7; *(LAS u32x4*)(lds + NS_QT + row * 128 + ((c ^ (row & 7)) << 4)) = qv[i]; }
#pragma unroll
              for (int i = 0; i < 2; ++i) { const int idx = tid + NTHREADS * i;
                  *(LAS u32x4*)(lds + NS_KC + (idx >> 3) * KPITCH + (idx & 7) * 16) = kv[i];
                  *(LAS u32x4*)(lds + NS_VC + (idx >> 4) * VCPITCH + (idx & 15) * 16) = vv[i]; } }
            { LAS float* el = (LAS float*)(lds + NS_ELUT); const LAS float* rl = (const LAS float*)(lds + NS_LUT) + g * 4;
              for (int i = tid; i < 64 + 4 * 256; i += NTHREADS) { const int k = i - 64, d = k & 255; float v = NEG_;
                  if (k >= 0 && d < LUTN) v = rl[8 * (d < 128 ? (int)lds[NS_BKT + d] : 31) + (k >> 8)];
                  el[i] = v; } }
            __syncthreads();
            NSA_LOADQ();
            const float b31c = lut_h[8 * 31];
            f32x16 pc[4];
            float mx = NEG_;
#pragma unroll
            for (int kq = 0; kq < 4; ++kq) {
#pragma unroll
                for (int r = 0; r < 16; ++r) pc[kq][r] = NEG_;
                if (kq < 2 * nkb) {
                    f32x16 p = {};
#pragma unroll
                    for (int ds = 0; ds < 4; ++ds) { const bf16x8 kf = *(const LAS bf16x8*)(lds + NS_KC + (32 * kq + r32) * KPITCH + (16 * ds + 8 * hi) * 2);
                        p = __builtin_amdgcn_mfma_f32_32x32x16_bf16(kf, qr[ds], p, 0, 0, 0); }
                    if (32 * kq + 31 >= cur - 2) {
#pragma unroll
                        for (int r = 0; r < 16; ++r) { const int j = 32 * kq + crow(r, hi); const int dist = tq - (64 * j + 63); const bool ok = dist >= 0;
                            const int bk = dist < 0 ? 0 : (dist > 127 ? 31 : (int)lds[NS_BKT + dist]);
                            const float sv = ok ? p[r] + lut_h[8 * bk] : NEG_; pc[kq][r] = sv; mx = fmaxf(mx, sv); }
                    } else {
#pragma unroll
                        for (int r = 0; r < 16; ++r) { const float sv = p[r] + b31c; pc[kq][r] = sv; mx = fmaxf(mx, sv); } }
                } }
            { const auto rr = __builtin_amdgcn_permlane32_swap(__float_as_uint(mx), __float_as_uint(mx), false, false); mx = fmaxf(__uint_as_float(rr[0]), __uint_as_float(rr[1])); }
            float lsum = 0.f;
            if (cur == 0) {
#pragma unroll
                for (int kq = 0; kq < 2; ++kq)
#pragma unroll
                    for (int r = 0; r < 16; ++r) { const float e = (pc[kq][r] > -1e29f) ? ex2(pc[kq][r] - mx) : 0.f; pc[kq][r] = e; lsum += e; }
            } else {
#pragma unroll
                for (int kq = 0; kq < 4; ++kq)
                    if (kq < 2 * nkb) {
#pragma unroll
                        for (int r = 0; r < 16; ++r) { const float e = ex2(pc[kq][r] - mx); pc[kq][r] = e; lsum += e; } }
            }
            { const auto rr = __builtin_amdgcn_permlane32_swap(__float_as_uint(lsum), __float_as_uint(lsum), false, false); lsum = __uint_as_float(rr[0]) + __uint_as_float(rr[1]); }
            const float inv = rcp(fmaxf(lsum, 1e-30f));
            f32x16 oc[2] = {};
#pragma unroll
            for (int kq = 0; kq < 4; ++kq) {
                if (kq < 2 * nkb) {
#pragma unroll
                    for (int r = 0; r < 16; ++r) pc[kq][r] *= inv;
#pragma unroll
                    for (int s2 = 0; s2 < 2; ++s2) {
                        u32x4 pw; pw.x = cvt_pk_bf16(pc[kq][8 * s2 + 0], pc[kq][8 * s2 + 1]); pw.y = cvt_pk_bf16(pc[kq][8 * s2 + 2], pc[kq][8 * s2 + 3]);
                        pw.z = cvt_pk_bf16(pc[kq][8 * s2 + 4], pc[kq][8 * s2 + 5]); pw.w = cvt_pk_bf16(pc[kq][8 * s2 + 6], pc[kq][8 * s2 + 7]);
                        const bf16x8 pf = __builtin_bit_cast(bf16x8, pw);
#pragma unroll
                        for (int dt = 0; dt < 2; ++dt) { const LAS unsigned char* vp = lds + NS_VC + (32 * dt + r32) * VCPITCH + (32 * kq + 16 * s2 + 4 * hi) * 2;
                            const u32x2 lo = *(const LAS u32x2*)vp, hi8 = *(const LAS u32x2*)(vp + 16);
                            const u32x4 vw = {lo.x, lo.y, hi8.x, hi8.y};
                            oc[dt] = __builtin_amdgcn_mfma_f32_32x32x16_bf16(__builtin_bit_cast(bf16x8, vw), pf, oc[dt], 0, 0, 0); } }
#pragma unroll
                    for (int r = 0; r < 16; ++r) { float v = pc[kq][r];
                        v += __uint_as_float(__builtin_amdgcn_update_dpp(0u, __float_as_uint(v), 0xB1, 0xF, 0xF, false)); v += __uint_as_float(__builtin_amdgcn_update_dpp(0u, __float_as_uint(v), 0x4E, 0xF, 0xF, false));
                        if (hh == 0) imp[tl * IMPP + 32 * kq + crow(r, hi)] = v; }
                } }
            const float gc = gate3[0];
            { LAS bf16_t* att = (LAS bf16_t*)(lds + NS_ATT);
#pragma unroll
              for (int dt = 0; dt < 2; ++dt)
#pragma unroll
                for (int q4 = 0; q4 < 4; ++q4) { u32x2 w; w.x = pk2(gc * oc[dt][4 * q4 + 0], gc * oc[dt][4 * q4 + 1]); w.y = pk2(gc * oc[dt][4 * q4 + 2], gc * oc[dt][4 * q4 + 3]);
                    *(LAS u32x2*)(att + tl * ATTP + hh * 64 + 32 * dt + 8 * q4 + 4 * hi) = w; } }
            __syncthreads();
        }
        u32x4 pk, pv;
        { const int tidp = tid_of(wave); const int trow = tidp >> 3, tch = (tidp & 7) * 8;
          pk = *(const u32x4*)((const bf16_t*)(A.ws + WS_KP) + (size_t)(1 * 2 + g) * T_ * 64 + (rowbase + trow) * 64 + tch);
          pv = *(const u32x4*)((const bf16_t*)(A.ws + WS_VT) + (size_t)(1 * 128 + g * 64) * T_ + (size_t)trow * T_ + rowbase + tch); }
        {
            const int tid = tid_of(wave);
            const LAS float* imp = (const LAS float*)(lds + NS_IMP); LAS unsigned short* sel16 = (LAS unsigned short*)(lds + NS_SEL);
            const int tk = tid >> 3, sub = tid & 7, jb = sub * 16;
            const int need = 16 - (cur + 1 < 3 ? cur + 1 : 3);
            unsigned key[16];
#pragma unroll
            for (int c = 0; c < 16; ++c) { const int j = jb + c; const bool cand = (j >= 1) && (j <= cur - 2); const float v = (j < nkb * 64) ? imp[tk * IMPP + j] : 0.f; key[c] = cand ? __float_as_uint(v) + 1u : 0u; }
            unsigned T = 0u;
#pragma unroll 1
            for (int bit = 30; bit >= 0; --bit) { const unsigned t = T | (1u << bit); int cnt = 0;
#pragma unroll
                for (int c = 0; c < 16; ++c) cnt += (key[c] >= t) ? 1 : 0;
                cnt += __builtin_amdgcn_update_dpp(0, cnt, 0xB1, 0xF, 0xF, false); cnt += __builtin_amdgcn_update_dpp(0, cnt, 0x4E, 0xF, 0xF, false); cnt += __builtin_amdgcn_update_dpp(0, cnt, 0x141, 0xF, 0xF, false);
                if (cnt >= need) T = t;
                if (cnt == need) break; }
            int ngt = 0, neq = 0;
#pragma unroll
            for (int c = 0; c < 16; ++c) { ngt += (key[c] > T) ? 1 : 0; neq += (key[c] == T && T != 0u) ? 1 : 0; }
            int ngt_all = ngt; ngt_all += __builtin_amdgcn_update_dpp(0, ngt_all, 0xB1, 0xF, 0xF, false); ngt_all += __builtin_amdgcn_update_dpp(0, ngt_all, 0x4E, 0xF, 0xF, false); ngt_all += __builtin_amdgcn_update_dpp(0, ngt_all, 0x141, 0xF, 0xF, false);
            int pre = neq;
            { int t1 = __builtin_amdgcn_update_dpp(0, pre, 0x111, 0xF, 0xF, false); if (sub >= 1) pre += t1; int t2 = __builtin_amdgcn_update_dpp(0, pre, 0x112, 0xF, 0xF, false); if (sub >= 2) pre += t2; int t4 = __builtin_amdgcn_update_dpp(0, pre, 0x114, 0xF, 0xF, false); if (sub >= 4) pre += t4; pre -= neq; }
            const int rem = need - ngt_all;
            unsigned mask = 0; int run = pre;
#pragma unroll
            for (int c = 0; c < 16; ++c) { const int j = jb + c; const bool forced = (j == 0) || (j == cur) || (j == cur - 1); bool sel = key[c] > T;
                if (key[c] == T && T != 0u) { sel = run < rem; ++run; }
                if (sel || forced) mask |= (1u << c); }
            sel16[tk * 8 + sub] = (unsigned short)mask;
            __syncthreads();
        }
#pragma unroll 1
        for (int br = 0; br < 2; ++br) {
            NSA_IDS();
            NSA_LOADQ();
            const float b31 = lut_h[8 * 31];
            const LAS float* lute = (const LAS float*)(lds + NS_ELUT) + 64 + 256 * hh + tq - 4 * hi - 59;
            const LAS unsigned* selw = (const LAS unsigned*)(lds + NS_SEL) + tl * 4;
            const bf16_t* Kp = (const bf16_t*)(A.ws + WS_KP) + (size_t)((br == 0 ? 1 : 2) * 2 + g) * T_ * 64;
            const bf16_t* Vp = (const bf16_t*)(A.ws + WS_VT) + (size_t)((br == 0 ? 1 : 2) * 128 + g * 64) * T_;
            const int nblk = br == 0 ? (cur + 1 < 4 ? cur + 1 : 4) : (cur < 8 ? cur + 1 : 9);
#define KBI(i_) (br == 0 ? ((i_) == 0 ? 0 : cur - (nblk - 1 - (i_))) : cur - (i_))
            SoftSt st; st.m = 0.f; st.l = 0.f; st.o[0] = (f32x16){}; st.o[1] = (f32x16){};
            const int trow = tid >> 3, tch = (tid & 7) * 8;
            const bf16_t* kg = Kp + (rowbase + trow) * 64 + tch;
            const bf16_t* vg = Vp + (size_t)trow * T_ + rowbase + tch;
            LAS unsigned char* kl = lds + NS_KV + trow * KPITCH + tch * 2;
            LAS unsigned char* vl = lds + NS_KV + trow * KPITCH + ((tch >> 4) * 16 + ((tch >> 3) & 1) * 4) * 2;
#define NSA_LD(kr, vr, i_) asm volatile("global_load_dwordx4 %0, %2, off\n\tglobal_load_dwordx4 %1, %3, off" : "=&v"(kr), "=&v"(vr) : "v"(kg + (long)KBC(i_) * 4096), "v"(vg + (long)KBC(i_) * 64) : "memory")
#define NSA_WAIT(kr, vr, n) asm volatile("s_waitcnt vmcnt(" #n ")" : "+v"(kr), "+v"(vr) : : "memory")
#define NSA_ST(kr, vr, i_) do { *(LAS u32x4*)(kl + ((i_) & 1) * 18432) = kr; \
                *(LAS u32x2*)(vl + ((i_) & 1) * 18432 + 9216) = (u32x2){vr.x, vr.y}; *(LAS u32x2*)(vl + ((i_) & 1) * 18432 + 9216 + 16) = (u32x2){vr.z, vr.w}; } while (0)
#define NSA_STEP(i_) do { const int kb = KBI(i_); const bool masked = (cur - kb <= 2) || (br == 1 && cur - kb == 8); bool selected = true; \
                if (br == 0) selected = (selw[kb >> 5] >> (kb & 31)) & 1u; \
                if (__ballot(selected) != 0ull) { const float cinit = selected ? (masked ? 0.f : b31) : NEG_; \
                    attn_step(lds + NS_KV + ((i_) & 1) * 18432, lds + NS_KV + ((i_) & 1) * 18432 + 9216, qr, cinit, masked, (i_) == 0, lute - 64 * kb - ((br == 1 && cur - kb == 8) ? 320 : 0), st, r32, hi); } } while (0)
#define KBC(i_) KBI((i_) < nblk ? (i_) : nblk - 1)
            u32x4 kA, vA, kB, vB;
            asm volatile("" : "+v"(qr[0]), "+v"(qr[1]), "+v"(qr[2]), "+v"(qr[3]));
            kA = pk; vA = pv; NSA_ST(kA, vA, 0);
            NSA_LD(kA, vA, 1); NSA_LD(kB, vB, 2);
            __syncthreads();
#pragma unroll 1
            for (int i = 0; i < nblk; i += 2) {
                NSA_STEP(i);
                NSA_WAIT(kA, vA, 2); NSA_ST(kA, vA, 1); NSA_LD(kA, vA, i + 3);
                __syncthreads();
                if (i + 1 >= nblk) break;
                NSA_STEP(i + 1);
                NSA_WAIT(kB, vB, 2); NSA_ST(kB, vB, 0); NSA_LD(kB, vB, i + 4);
                __syncthreads();
            }
            asm volatile("s_waitcnt vmcnt(0)" : "+v"(kA), "+v"(vA), "+v"(kB), "+v"(vB) : : "memory");
            if (br == 0) {
                pk = *(const u32x4*)((const bf16_t*)(A.ws + WS_KP) + (size_t)(2 * 2 + g) * T_ * 64 + (rowbase + trow) * 64 + tch + (long)cur * 4096);
                pv = *(const u32x4*)((const bf16_t*)(A.ws + WS_VT) + (size_t)(2 * 128 + g * 64) * T_ + (size_t)trow * T_ + rowbase + tch + (long)cur * 64); }
#undef KBC
#undef NSA_LD
#undef NSA_WAIT
#undef NSA_ST
#undef NSA_STEP
#undef KBI
            if (br == 0 && cur >= 4) {
                LAS float* osp = (LAS float*)(lds + NS_OSP); LAS float* lsp = (LAS float*)(lds + NS_LSP); LAS float* mrf = (LAS float*)(lds + NS_MREF);
                { f32x4 z = {0.f, 0.f, 0.f, 0.f};
                  for (int i = tid; i < 4224; i += NTHREADS) *(LAS f32x4*)(lds + NS_OSP + i * 16) = z; }
                LAS float* scl = (LAS float*)(lds + NS_SLOT + 512);
                { const float ld = sum32(st.l); const int e_ = (int)((__float_as_uint(fmaxf(ld, 1e-30f)) >> 23) & 255u) - 126;
                  if (hi == 0) { mrf[32 * wave + r32] = st.m - (float)(20 - e_); scl[32 * wave + r32] = __uint_as_float((unsigned)(127 + 20 - e_) << 23); } }
                if (tid == 0) *(LAS int*)(lds + NS_QCTR) = 1;
                __syncthreads();
                const bf16_t* Kf1 = (const bf16_t*)(A.ws + WS_KF) + ((size_t)g * (T_ / 64) + (rowbase >> 6)) * 4096 + lane * 8;
                const bf16_t* Vf1 = (const bf16_t*)(A.ws + WS_VF) + ((size_t)g * (T_ / 64) + (rowbase >> 6)) * 4096 + lane * 8;
                LAS unsigned char* slot = lds + NS_SLOT + wave * 64;
                const LAS unsigned* selm = (const LAS unsigned*)(lds + NS_SEL);
                LAS int* qctr = (LAS int*)(lds + NS_QCTR);
#pragma unroll 1
                for (;;) {
                    int kbv = 0; if (lane == 0) kbv = __hip_atomic_fetch_add(qctr, 1, __ATOMIC_RELAXED, __HIP_MEMORY_SCOPE_WORKGROUP);
                    const int kb = __builtin_amdgcn_readfirstlane(kbv);
                    if (kb > cur - 3) break;
                    const bool bit = (selm[lane * 4 + (kb >> 5)] >> (kb & 31)) & 1u;
                    const unsigned long long msk = __ballot(bit); const int cnt = __popcll(msk);
                    if (cnt == 0) continue;
                    if (bit) slot[__builtin_amdgcn_mbcnt_hi((unsigned)(msk >> 32), __builtin_amdgcn_mbcnt_lo((unsigned)msk, 0u))] = (unsigned char)lane;
                    bf16x8 kf[2][4], vf[2][2][2];
#pragma unroll
                    for (int kt = 0; kt < 2; ++kt)
#pragma unroll
                        for (int ds = 0; ds < 4; ++ds) kf[kt][ds] = *(const bf16x8*)(Kf1 + (size_t)kb * 4096 + (kt * 4 + ds) * 512);
#pragma unroll
                    for (int kt = 0; kt < 2; ++kt)
#pragma unroll
                        for (int s2 = 0; s2 < 2; ++s2)
#pragma unroll
                            for (int dt = 0; dt < 2; ++dt) vf[kt][s2][dt] = *(const bf16x8*)(Vf1 + (size_t)kb * 4096 + ((kt * 2 + s2) * 2 + dt) * 512);
                    LDS_WAIT(); asm volatile("" ::: "memory");
#pragma unroll 1
                    for (int c8 = 0; c8 * 8 < cnt; ++c8) {
                        const int si = c8 * 8 + (r32 >> 2); const bool valid = si < cnt; const int tok = slot[valid ? si : 0]; const int row = tok * 4 + hh;
                        bf16x8 qf[4];
#pragma unroll
                        for (int ds = 0; ds < 4; ++ds) qf[ds] = *(const LAS bf16x8*)(lds + NS_QT + row * 128 + (((2 * ds + hi) ^ (row & 7)) << 4));
                        const float c0 = valid ? b31 - mrf[row] : NEG_;
                        f32x16 sc[2], cvec;
#pragma unroll
                        for (int r = 0; r < 16; ++r) cvec[r] = c0;
#pragma unroll
                        for (int ds = 0; ds < 4; ++ds)
#pragma unroll
                            for (int kt = 0; kt < 2; ++kt) sc[kt] = __builtin_amdgcn_mfma_f32_32x32x16_bf16(kf[kt][ds], qf[ds], ds == 0 ? cvec : sc[kt], 0, 0, 0);
                        f32x2 ls2 = {0.f, 0.f}; f32x16 ot[2] = {};
#pragma unroll
                        for (int kt = 0; kt < 2; ++kt)
#pragma unroll
                            for (int s2 = 0; s2 < 2; ++s2) {
#pragma unroll
                                for (int j = 0; j < 8; j += 2) { const float e0 = ex2(sc[kt][8 * s2 + j]), e1 = ex2(sc[kt][8 * s2 + j + 1]); sc[kt][8 * s2 + j] = e0; sc[kt][8 * s2 + j + 1] = e1; ls2 += (f32x2){e0, e1}; }
                                u32x4 pw; pw.x = cvt_pk_bf16(sc[kt][8 * s2 + 0], sc[kt][8 * s2 + 1]); pw.y = cvt_pk_bf16(sc[kt][8 * s2 + 2], sc[kt][8 * s2 + 3]);
                                pw.z = cvt_pk_bf16(sc[kt][8 * s2 + 4], sc[kt][8 * s2 + 5]); pw.w = cvt_pk_bf16(sc[kt][8 * s2 + 6], sc[kt][8 * s2 + 7]);
                                const bf16x8 pf = __builtin_bit_cast(bf16x8, pw);
#pragma unroll
                                for (int dt = 0; dt < 2; ++dt) ot[dt] = __builtin_amdgcn_mfma_f32_32x32x16_bf16(vf[kt][s2][dt], pf, ot[dt], 0, 0, 0); }
                        if (__any(!(ls2.x + ls2.y <= 0x1p44f))) {
                            ls2 = (f32x2){0.f, 0.f}; ot[0] = (f32x16){}; ot[1] = (f32x16){};
#pragma unroll
                            for (int kt = 0; kt < 2; ++kt)
#pragma unroll
                                for (int s2 = 0; s2 < 2; ++s2) {
#pragma unroll
                                    for (int j = 0; j < 8; j += 2) { const float e0 = fminf(sc[kt][8 * s2 + j], 0x1p44f), e1 = fminf(sc[kt][8 * s2 + j + 1], 0x1p44f); sc[kt][8 * s2 + j] = e0; sc[kt][8 * s2 + j + 1] = e1; ls2 += (f32x2){e0, e1}; }
                                    u32x4 pw; pw.x = cvt_pk_bf16(sc[kt][8 * s2 + 0], sc[kt][8 * s2 + 1]); pw.y = cvt_pk_bf16(sc[kt][8 * s2 + 2], sc[kt][8 * s2 + 3]);
                                    pw.z = cvt_pk_bf16(sc[kt][8 * s2 + 4], sc[kt][8 * s2 + 5]); pw.w = cvt_pk_bf16(sc[kt][8 * s2 + 6], sc[kt][8 * s2 + 7]);
                                    const bf16x8 pf = __builtin_bit_cast(bf16x8, pw);
#pragma unroll
                                    for (int dt = 0; dt < 2; ++dt) ot[dt] = __builtin_amdgcn_mfma_f32_32x32x16_bf16(vf[kt][s2][dt], pf, ot[dt], 0, 0, 0); } }
                        float ls = ls2.x + ls2.y;
                        { const auto rr = __builtin_amdgcn_permlane32_swap(__float_as_uint(ls), __float_as_uint(ls), false, false); ls = __uint_as_float(rr[0]) + __uint_as_float(rr[1]); }
                        { float ma = MX3(__builtin_fabsf(ot[0][0]), __builtin_fabsf(ot[1][0]), __builtin_fabsf(ot[0][1]));
#pragma unroll
                          for (int r = 2; r < 16; r += 2) ma = MX3(ma, __builtin_fabsf(ot[0][r]), __builtin_fabsf(ot[1][r - 1])), ma = MX3(ma, __builtin_fabsf(ot[0][r + 1]), __builtin_fabsf(ot[1][r]));
                          ma = fmaxf(ma, __builtin_fabsf(ot[1][15]));
                          if (__any(!(ma <= 6.0e7f))) {
#pragma unroll
                              for (int dt = 0; dt < 2; ++dt)
#pragma unroll
                                  for (int r = 0; r < 16; ++r) ot[dt][r] = __builtin_amdgcn_fmed3f(ot[dt][r], -6.0e7f, 6.0e7f); } }
                        if (valid) {
#pragma unroll
                            for (int dt = 0; dt < 2; ++dt)
#pragma unroll
                                for (int r = 0; r < 16; ++r) __hip_atomic_fetch_add((LAS int*)osp + row * OSPP + 32 * dt + crow(r, hi), (int)ot[dt][r], __ATOMIC_RELAXED, __HIP_MEMORY_SCOPE_WORKGROUP);
                            if (hi == 0) __hip_atomic_fetch_add((LAS int*)lsp + row, (int)fminf(ls, 6.0e7f), __ATOMIC_RELAXED, __HIP_MEMORY_SCOPE_WORKGROUP); }
                    }
                }
                __syncthreads();
                { const int row = 32 * wave + r32; const float isr = rcp(scl[row]);
#pragma unroll
                  for (int dt = 0; dt < 2; ++dt)
#pragma unroll
                    for (int r = 0; r < 16; ++r) st.o[dt][r] += (float)((const LAS int*)osp)[row * OSPP + 32 * dt + crow(r, hi)] * isr;
                  if (hi == 0) st.l += (float)((const LAS int*)lsp)[row] * isr; }
                __syncthreads();
            }
            const float lt = sum32(st.l);
            const float gg = (br == 0 ? gate3[1] : gate3[2]) * rcp(lt);
            LAS bf16_t* att = (LAS bf16_t*)(lds + NS_ATT);
            float ss = 0.f;
#pragma unroll
            for (int dt = 0; dt < 2; ++dt)
#pragma unroll
                for (int q4 = 0; q4 < 4; ++q4) { LAS u32x2* ap = (LAS u32x2*)(att + tl * ATTP + hh * 64 + 32 * dt + 8 * q4 + 4 * hi); const u32x2 pv = *ap;
                    const float a0 = bflo(pv.x) + gg * st.o[dt][4 * q4 + 0], a1 = bfhi(pv.x) + gg * st.o[dt][4 * q4 + 1], a2 = bflo(pv.y) + gg * st.o[dt][4 * q4 + 2], a3 = bfhi(pv.y) + gg * st.o[dt][4 * q4 + 3];
                    ss += (a0 * a0 + a1 * a1) + (a2 * a2 + a3 * a3);
                    u32x2 w; w.x = pk2(a0, a1); w.y = pk2(a2, a3); *ap = w; }
            if (br == 1) { ss = sum32(ss); ss += __uint_as_float(__builtin_amdgcn_update_dpp(0u, __float_as_uint(ss), 0xB1, 0xF, 0xF, false)); ss += __uint_as_float(__builtin_amdgcn_update_dpp(0u, __float_as_uint(ss), 0x4E, 0xF, 0xF, false));
                if (lane == (lane & 28)) ((LAS float*)(lds + NS_SS))[g * 64 + tl] = ss; }
        }
        __syncthreads();
        { const int tid = tid_of(wave);
          const LAS float* ssq = (const LAS float*)(lds + NS_SS); const LAS bf16_t* att = (const LAS bf16_t*)(lds + NS_ATT);
          bf16_t* AB = (bf16_t*)(A.ws + WS_AB);
#pragma unroll
          for (int it = 0; it < 4; ++it) { const int idx = it * NTHREADS + tid; const int row = idx >> 5, c8 = idx & 31;
              const float ri = g == 0 ? 1.0f : __builtin_amdgcn_rsqf((ssq[row] + ssq[64 + row]) * (1.f / 512.f) + EPS_);
              const u32x4 w = *(const LAS u32x4*)(att + row * ATTP + c8 * 8);
              u32x4 o; o.x = pk2(bflo(w.x) * ri, bfhi(w.x) * ri); o.y = pk2(bflo(w.y) * ri, bfhi(w.y) * ri); o.z = pk2(bflo(w.z) * ri, bfhi(w.z) * ri); o.w = pk2(bflo(w.w) * ri, bfhi(w.w) * ri);
              *(u32x4*)(AB + (rowbase + 64 * tile + row) * 1024 + g * 256 + c8 * 8) = o; }
          if (g == 1) {
#pragma unroll
              for (int it = 0; it < 4; ++it) { const int idx = it * NTHREADS + tid; const int row = idx >> 5, c8 = idx & 31;
                  const float ri = __builtin_amdgcn_rsqf((ssq[row] + ssq[64 + row]) * (1.f / 512.f) + EPS_);
                  u32x4* p = (u32x4*)(AB + (rowbase + 64 * tile + row) * 1024 + c8 * 8); const u32x4 w = *p;
                  u32x4 o; o.x = pk2(bflo(w.x) * ri, bfhi(w.x) * ri); o.y = pk2(bflo(w.y) * ri, bfhi(w.y) * ri); o.z = pk2(bflo(w.z) * ri, bfhi(w.z) * ri); o.w = pk2(bflo(w.w) * ri, bfhi(w.w) * ri);
                  *p = o; } }
        }
        __syncthreads();
    }
}

__device__ __forceinline__ void nsa_lut(const Args& A, LAS unsigned char* lds, int tid) {
    LAS float* lut = (LAS float*)(lds + NS_LUT);
    if (tid < 256) lut[tid] = A.in[I_RELB][tid] * LOG2E_;
    if (tid < 128) { const int d = tid; int bk; if (d < 16) bk = d; else { bk = 16 + (int)(logf((float)d * (1.0f / 16.0f)) / 2.0794415416798357f * 16.0f); bk = bk > 31 ? 31 : bk; }
        lds[NS_BKT + d] = (unsigned char)bk; }
    __syncthreads();
}

#define XB_TMO      128
#define XB_XCNT(j)  (256  + 64 * (j))
#define XB_XSUB(j)  (1280 + 64 * (j))
#define XB_XGEN(j)  (2304 + 64 * (j))
#define XB_TOP      3328
#define XB_TOPGEN   3392
#define XCD_BAR_WORDS 3456
#define XB_SPIN_CAP (1u << 20)
__device__ __forceinline__ unsigned xb_ld(unsigned* p)              { return __hip_atomic_load(p, __ATOMIC_RELAXED, __HIP_MEMORY_SCOPE_AGENT); }
__device__ __forceinline__ unsigned xb_add(unsigned* p, unsigned v) { return __hip_atomic_fetch_add(p, v, __ATOMIC_RELAXED, __HIP_MEMORY_SCOPE_AGENT); }
__device__ __forceinline__ unsigned xb_xcc_id() { return (unsigned)__builtin_amdgcn_s_getreg((3 << 11) | 20) & 0xFu; }
#define XB_SPIN(cond, bar) do { unsigned _sp = 0; while (cond) { __builtin_amdgcn_s_sleep(1); \
    if ((++_sp & 255u) == 0u) { if (xb_ld(&(bar)[XB_TMO])) break; if (_sp > XB_SPIN_CAP) { atomicAdd(&(bar)[XB_TMO], 1u); break; } } } } while (0)
struct XcdBarrier { unsigned* bar; unsigned x; volatile LAS unsigned* st; };
__device__ __forceinline__ XcdBarrier xcd_barrier_post(unsigned* bar, volatile LAS unsigned* st, bool leader) {
    XcdBarrier b; b.bar = bar; b.x = xb_xcc_id(); b.st = st;
    if (leader) (void)xb_add(&bar[XB_XCNT(b.x)], 1u);
    return b;
}
__device__ __forceinline__ void xcd_barrier_complete(unsigned* bar, unsigned x, unsigned& nloc, unsigned& nx) {
    const unsigned G = gridDim.x * gridDim.y * gridDim.z;
    unsigned sum, cnt, mine, sp = 0u;
    for (;;) {
        sum = 0u; cnt = 0u; mine = 0u;
#pragma unroll
        for (unsigned j = 0; j < 16; ++j) { const unsigned c = xb_ld(&bar[XB_XCNT(j)]); sum += c; cnt += (c > 0u) ? 1u : 0u; mine = (j == x) ? c : mine; }
        if (sum == G) break;
        __builtin_amdgcn_s_sleep(1);
        if ((++sp & 255u) == 0u) { if (xb_ld(&bar[XB_TMO])) break; if (sp > XB_SPIN_CAP) { atomicAdd(&bar[XB_TMO], 1u); break; } }
    }
    nloc = mine > 0u ? mine : 1u; nx = cnt > 0u ? cnt : 1u;
}
__device__ __forceinline__ void xcd_barrier(const XcdBarrier& b, bool leader) {
    asm volatile("s_waitcnt vmcnt(0)" ::: "memory");
    __syncthreads();
    if (leader) {
        unsigned* bar = b.bar;
        __builtin_amdgcn_s_waitcnt(0);
        unsigned nloc = b.st[0], nx = b.st[1];
        if (nloc == 0u) { xcd_barrier_complete(bar, b.x, nloc, nx); b.st[0] = nloc; b.st[1] = nx; }
        const unsigned old = xb_add(&bar[XB_XSUB(b.x)], 1u);
        const unsigned gen = old / nloc;
        if (old + 1u == (gen + 1u) * nloc) {
            __builtin_amdgcn_fence(__ATOMIC_RELEASE, "agent");
            asm volatile("s_waitcnt vmcnt(0)" ::: "memory");
            const unsigned og = xb_add(&bar[XB_TOP], 1u);
            __builtin_amdgcn_fence(__ATOMIC_ACQUIRE, "agent");
            const unsigned tg = og / nx;
            if (og + 1u == (tg + 1u) * nx) xb_add(&bar[XB_TOPGEN], 1u);
            else XB_SPIN(xb_ld(&bar[XB_TOPGEN]) == tg, bar);
            xb_add(&bar[XB_XGEN(b.x)], 1u);
            asm volatile("s_waitcnt vmcnt(0)" ::: "memory");
        } else {
            __builtin_amdgcn_fence(__ATOMIC_ACQUIRE, "agent");
            XB_SPIN(xb_ld(&bar[XB_XGEN(b.x)]) == gen, bar);
            asm volatile("s_waitcnt vmcnt(0)" ::: "memory");
        }
    }
    __syncthreads();
}

constexpr int NPH = 1 + 9 * NL_;
#ifndef PH_MASK
#define PH_MASK 0xFFFF
#endif
#define PHON(k) (((PH_MASK) >> (k)) & 1)
#ifndef REPEAT_MASK
#define REPEAT_MASK 0
#endif
__global__ void __launch_bounds__(NTHREADS, 2) trunk_fwd(Args args) {
    extern __shared__ __attribute__((aligned(16))) unsigned char lds_raw[];
    LAS unsigned char* lds = (LAS unsigned char*)lds_raw;
    cg::grid_group grid = cg::this_grid();
    const int G = gridDim.x;
    LAS unsigned char* xl = lds + RING_BYTES;
    volatile LAS unsigned* bst = (volatile LAS unsigned*)(lds + LDS_BYTES - 16);
    const int wv_ = __builtin_amdgcn_readfirstlane(threadIdx.x >> 6);
    if (threadIdx.x < 4) bst[threadIdx.x] = 0u;
    __syncthreads();
    XcdBarrier xbar; xbar.bar = (unsigned*)args.ws; xbar.x = 0; xbar.st = bst;

    for (int ph = args.ph_lo; ph < args.ph_hi; ++ph) {
#define PH_IDS() const int tid = tid_of(wv_); const int lane = tid & 63, wave = wv_; (void)lane; (void)wave
        int c = blockIdx.x; asm volatile("" : "+s"(c));
        Args A = args; { size_t z_ = 0; asm volatile("" : "+s"(z_)); A.ws = args.ws + z_; A.out = args.out + z_; }
        unsigned char* ws = A.ws;
        bf16_t* HB = (bf16_t*)(ws + WS_HB); float* RS = (float*)(ws + WS_RS);
        if (ph == 0) { PH_IDS(); if (blockIdx.x == 0) { for (int i = tid; i < 16384; i += NTHREADS) ((unsigned*)args.ws)[i] = 0u; }
            if (PHON(0)) prologue_phase(A, lds, tid, wave, lane); }
        else {
            const int l = (ph - 1) / 9, si_ = (ph - 1) % 9, sp = si_ < 6 ? si_ : si_ + 1;
            unsigned char* wl = ws + WS_W + (size_t)l * WL_STRIDE;
            const int nrep = ((REPEAT_MASK >> sp) & 1) ? 2 : 1;
#pragma unroll 1
            for (int rep = 0; rep < nrep; ++rep) {
            if (rep) grid.sync();
            int nplain = 0;
            if (sp == 0) {
                pg8::Gemm g{HB, (const bf16_t*)(wl + W_INA), 1024, 1024, 1024}; pg8::GenOrder S; S.kind = 0; S.t.init(T_, 2048, 1024, 1024, G, c);
                pg8::EpiG1 E{(bf16_t*)(ws + WS_QB), (bf16_t*)(ws + WS_KP), (float*)(ws + WS_GATES), (bf16_t*)(ws + WS_YG), (bf16_t*)(ws + WS_XR), RS, (bf16_t*)(ws + WS_KF)};
                { PH_IDS(); if (PHON(1)) pg8::gemm_phase<false>(lds, xl, g, S, E, tid); }
                nplain = 1;
            } else if (sp == 1) { PH_IDS();
                if (PHON(2)) { int rnd = 0, it = c; do { lru_item_1p(A, l, it >> 7, (G == 256 && (rnd & 1)) ? 127 - (it & 127) : (it & 127), lds, wave); it += G; ++rnd; } while (it < 512); }
                __syncthreads();
                if (PHON(8)) for (int it = c; it < 128; it += G) compress_item(A, l, it, lds, wave);
                __syncthreads();
                nplain = (l == 0) ? 4 : 0;
            } else if (sp == 2) { PH_IDS();
#ifndef LRU2_REP
#define LRU2_REP 1
#endif
#ifndef NSA_REP
#define NSA_REP 1
#endif
#ifndef NSA_VARIANT
#define NSA_VARIANT 0
#endif
                if (wave >= 4) __builtin_amdgcn_s_setprio(1);
                if (PHON(4)) nsa_lut(A, lds, tid);
                if (NSA_REP > 1) for (int pr = c; pr < 256; pr += G) { const int b = pr >> 6, p = pr & 63; nsa_item<NSA_VARIANT>(A, l, b, 127 - p, lds, wave); nsa_item<NSA_VARIANT>(A, l, b, p, lds, wave); }
                if (PHON(4)) for (int pr = c; pr < 256; pr += G) { const int b = (G == 256) ? (pr & 7) >> 1 : pr >> 6, p = (G == 256) ? ((pr & 1) << 5) + (pr >> 3) : pr & 63;
#pragma unroll 1
                    for (int k2 = 0; k2 < 2; ++k2) { int tl_ = k2 ? p : 127 - p; asm volatile("" : "+s"(tl_)); nsa_item<0>(A, l, b, tl_, lds, wave); } }
                __builtin_amdgcn_s_setprio(0);
            } else if (sp == 3 || sp == 7) {
                pg8::Gemm g; pg8::ResidOrder S; S.kind = (G == 256) ? 0 : 3; pg8::EpiResid E; E.XB = HB; E.SL = (unsigned long long*)(ws + WS_SLOT); E.RS4 = RS; E.out_f32 = nullptr; E.eps = EPS_;
                if (sp == 3) { g = pg8::Gemm{(const bf16_t*)(ws + WS_AB), (const bf16_t*)(wl + W_OUT), 1024, 1024, 1024}; E.gpost = A.in[I_LN_MIX_POST] + l * D_; E.tag = 1u + 3u * l; }
                else { g = pg8::Gemm{(const bf16_t*)(ws + WS_CO), (const bf16_t*)(wl + W_XO), 1024, 1024, 1024}; E.gpost = A.in[I_LN_X_POST] + l * D_; E.tag = 2u + 3u * l; }
                S.t.init(T_, 1024, g.lda, g.ldb, G, c);
                PH_IDS(); if (PHON(5)) pg8::gemm_phase<false>(lds, xl, g, S, E, tid);
            } else if (sp == 9) {
                pg8::Gemm g{(const bf16_t*)(ws + WS_U), (const bf16_t*)(wl + W_2), FF_ / 2, FF_ / 2, FF_ / 2}; pg8::ResidOrder S; S.kind = (G == 256) ? 0 : 3;
                pg8::EpiResid E; E.XB = HB; E.SL = (unsigned long long*)(ws + WS_SLOT); E.RS4 = RS; E.out_f32 = (l + 1 == NL_) ? A.out : nullptr; E.gpost = A.in[I_LN_MLP_POST] + l * D_; E.tag = 3u + 3u * l;
                E.eps = EPS_ * (U8_SCALE * W8_SCALE) * (U8_SCALE * W8_SCALE);
                S.t.init(T_, 1024, g.lda, g.ldb, G, c);
                PH_IDS(); if (PHON(5)) pg8::gemm_phase<true>(lds, xl, g, S, E, tid);
            } else if (sp == 5) {
                pg8::Gemm g{(const bf16_t*)(ws + WS_CQ), (const bf16_t*)(ws + WS_CK) + (size_t)l * 1024 * 1024, 1024, 1024, 256}; pg8::GenOrder S; S.kind = 4; S.t.init(T_, 1024, 1024, 1024, G, c);
                pg8::EpiSoftmax E{(bf16_t*)(ws + WS_PP)}; PH_IDS(); if (PHON(6)) pg8::gemm_phase<false>(lds, xl, g, S, E, tid);
                nplain = 1;
            } else nplain = 1;
#pragma unroll 1
            for (int q = 0; q < nplain; ++q) {
                pg8::Gemm g; pg8::GenOrder S; S.kind = 0; pg8::EpiBf16 E; E.row_limit = 1 << 30; E.act = 0; E.rs = RS; E.rs_mode = 0; E.vf = nullptr;
                if (sp == 0 && q == 0) { g = pg8::Gemm{(const bf16_t*)(wl + W_INV), HB, 1024, 1024, 1024}; S.t.init(512, T_, 1024, 1024, G, c); E.O = (bf16_t*)(ws + WS_VT); E.ldc = T_; E.row_limit = 384; E.rs_mode = 2; E.vf = (bf16_t*)(ws + WS_VF); }
                else if (sp == 1) { const int ll = q >> 1; unsigned char* w2 = ws + WS_W + (size_t)ll * WL_STRIDE; S.t.init(1024, 1024, 1024, 1024, G, (c + 4 * G - 128 - 16 * q) % G); E.ldc = 1024;
                    if ((q & 1) == 0) { g = pg8::Gemm{(const bf16_t*)(ws + WS_MNB), (const bf16_t*)(w2 + W_XK), 1024, 1024, 1024}; E.O = (bf16_t*)(ws + WS_CK) + (size_t)ll * 1024 * 1024; }
                    else { g = pg8::Gemm{(const bf16_t*)(w2 + W_XV), (const bf16_t*)(ws + WS_MNB), 1024, 1024, 1024}; E.O = (bf16_t*)(ws + WS_CVT) + (size_t)ll * 1024 * 1024; } }
                else if (sp == 4) { g = pg8::Gemm{HB, (const bf16_t*)(wl + W_XQ), 1024, 1024, 1024}; S.t.init(T_, 1024, 1024, 1024, G, c); E.O = (bf16_t*)(ws + WS_CQ); E.ldc = 1024; E.rs_mode = 1; }
                else if (sp == 5) { g = pg8::Gemm{(const bf16_t*)(ws + WS_PP), (const bf16_t*)(ws + WS_CVT) + (size_t)l * 1024 * 1024, 1024, 1024, 256}; S.kind = 5; S.t.init(T_, 1024, 1024, 1024, G, c); E.O = (bf16_t*)(ws + WS_CO); E.ldc = 1024; }
                else { g = pg8::Gemm{HB, (const bf16_t*)(wl + W_1), 1024, 1024, 1024}; S.t.init(T_, FF_, 1024, 1024, G, c); E.O = (bf16_t*)(ws + WS_U); E.ldc = FF_; E.act = 2; E.rs_mode = 1; }
                PH_IDS(); if (PHON(7)) pg8::gemm_phase<false>(lds, xl, g, S, E, tid);
            }
            }
        }
        const bool local_seam = ph > 0 && ((ph - 1) % 9) == 4;
        if (ph + 1 < args.ph_hi && !local_seam) { const bool leader = tid_of(wv_) == 0; if (ph == 0) { grid.sync(); xbar = xcd_barrier_post((unsigned*)args.ws, bst, leader); } else xcd_barrier(xbar, leader); }
    }
}

#ifndef N_LAUNCH_MODE
#define N_LAUNCH_MODE 1
#endif
extern "C" void kernel_launch(void* const* d_in, const int* in_sizes, int n_in, void* d_out, int out_size, void* d_ws, size_t ws_size, hipStream_t stream) {
    static int grid = 0;
    if (grid == 0) {
        if (n_in != 30 || out_size != T_ * D_ || ws_size < WS_END) { fprintf(stderr, "kernel_launch: unexpected problem (n_in %d, out %d, ws %zu)\n", n_in, out_size, ws_size); grid = -1; return; }
        int dev = 0, cus = 0, per_cu = 0;
        (void)hipGetDevice(&dev); (void)hipDeviceGetAttribute(&cus, hipDeviceAttributeMultiprocessorCount, dev);
        if (hipFuncSetAttribute((const void*)trunk_fwd, hipFuncAttributeMaxDynamicSharedMemorySize, LDS_BYTES) != hipSuccess) { fprintf(stderr, "kernel_launch: hipFuncSetAttribute failed\n"); grid = -1; return; }
        if (hipOccupancyMaxActiveBlocksPerMultiprocessor(&per_cu, (const void*)trunk_fwd, NTHREADS, LDS_BYTES) != hipSuccess || per_cu < 1) { fprintf(stderr, "kernel_launch: occupancy query says %d\n", per_cu); per_cu = 1; }
        (void)hipGetLastError();
        grid = cus;
        if (grid > 256) grid = 256;
        if (grid != 256) grid &= ~3;
    }
    if (grid < 0) return;
    Args a{};
    for (int i = 0; i < 30; ++i) a.in[i] = (const float*)d_in[i];
    a.out = (float*)d_out; a.ws = (unsigned char*)d_ws;
#if N_LAUNCH_MODE == 1
    a.ph_lo = 0; a.ph_hi = NPH;
    { void* kargs[] = {&a};
      hipError_t e = hipLaunchCooperativeKernel((const void*)trunk_fwd, dim3(grid), dim3(NTHREADS), kargs, LDS_BYTES, stream);
      if (e != hipSuccess) fprintf(stderr, "kernel_launch: cooperative launch failed: %s (grid %d)\n", hipGetErrorString(e), grid); }
#else
    for (int ph = 0; ph < NPH; ++ph) { a.ph_lo = ph; a.ph_hi = ph + 1; void* kargs[] = {&a};
        hipError_t e = hipLaunchCooperativeKernel((const void*)trunk_fwd, dim3(grid), dim3(NTHREADS), kargs, LDS_BYTES, stream);
        if (e != hipSuccess) { fprintf(stderr, "kernel_launch: cooperative launch %d failed: %s (grid %d)\n", ph, hipGetErrorString(e), grid); break; } }
#endif
}
```
